# Optimizing an MI355X kernel written in HIP

```python
import math
import jax, jax.numpy as jnp
from jax import lax
import numpy as np

D_MODEL = 1024
BATCH = 4
SEQ = 8192
DEPTH = 2

N_A_LAYERS = DEPTH // 2
N_B_LAYERS = DEPTH - N_A_LAYERS
EPS = 1e-6

D_FF = 2816
FFN_RES = 0.5

HGRN_HEADS = 8
HGRN_EXPAND = 128
HGRN_F_DIM = HGRN_HEADS * HGRN_EXPAND
HGRN_V_HEAD = D_MODEL // HGRN_HEADS
HGRN_CHUNK = 64
HGRN_IN_DIM = 2 * HGRN_F_DIM + 2 * D_MODEL

DIFF_HEADS = 8
DIFF_HEAD_DIM = D_MODEL // (2 * DIFF_HEADS)
DIFF_V_DIM = 2 * DIFF_HEAD_DIM
DIFF_Q_DIM = 2 * DIFF_HEADS * DIFF_HEAD_DIM
DIFF_KV_DIM = 2 * DIFF_HEADS * DIFF_HEAD_DIM + DIFF_HEADS * DIFF_V_DIM
Q_BLOCK = 128

N_BUCKETS = 32
MAX_DISTANCE = 128

kernel_name = "yoco_hgrn2_diffattn_macaron"


def rmsnorm(x, w):
    xf = x.astype(jnp.float32)
    y = xf * lax.rsqrt(jnp.mean(xf * xf, axis=-1, keepdims=True) + EPS)
    return (y * w.astype(jnp.float32)).astype(x.dtype)


def swiglu(x, w_in, w_out):
    g, u = jnp.split(x @ w_in, 2, axis=-1)
    return (jax.nn.silu(g) * u) @ w_out


def to_heads(t, n_heads):
    b, s, _ = t.shape
    return t.reshape(b, s, n_heads, -1).transpose(0, 2, 1, 3)


def chunk_gated_recurrence(q, k, v, logf):
    b_, h_, s_, dk = q.shape
    dv = v.shape[-1]
    c = HGRN_CHUNK
    n = s_ // c
    q = q.reshape(b_, h_, n, c, dk)
    k = k.reshape(b_, h_, n, c, dk)
    v = v.reshape(b_, h_, n, c, dv)
    bcum = jnp.cumsum(logf.reshape(b_, h_, n, c, dk), axis=3)
    b_last = bcum[:, :, :, -1:, :]
    b_mid = bcum[:, :, :, c // 2 - 1:c // 2, :]
    u = jnp.einsum('bhncd,bhnce->bhnde', k * jnp.exp(b_last - bcum), v)
    decay = jnp.exp(b_last[:, :, :, 0, :])

    def step(s, xs):
        dec, un = xs
        return dec[..., None] * s + un, s

    s0 = jnp.zeros((b_, h_, dk, dv), jnp.float32)
    _, s_prev = lax.scan(step, s0, (jnp.moveaxis(decay, 2, 0), jnp.moveaxis(u, 2, 0)))
    s_prev = jnp.moveaxis(s_prev, 0, 2)
    o_inter = jnp.einsum('bhncd,bhnde->bhnce', q * jnp.exp(bcum), s_prev)
    qi = q * jnp.exp(bcum - b_mid)
    ki = k * jnp.exp(b_mid - bcum)
    a = jnp.einsum('bhncd,bhnmd->bhncm', qi, ki)
    mask = jnp.tril(jnp.ones((c, c), dtype=bool))
    a = jnp.where(mask, a, 0.0)
    o_intra = jnp.einsum('bhncm,bhnme->bhnce', a, v)
    return (o_inter + o_intra).reshape(b_, h_, s_, dv)


def hgrn2_mixer(h, w_in, lb, gnorm_w, w_out):
    b_, s_, _ = h.shape
    q, f, i, g = jnp.split(h @ w_in, [HGRN_F_DIM, 2 * HGRN_F_DIM, 2 * HGRN_F_DIM + D_MODEL], axis=-1)
    q = jax.nn.silu(q.astype(jnp.float32))
    f = lb + (1.0 - lb) * jax.nn.sigmoid(f.astype(jnp.float32))
    k = 1.0 - f
    o = chunk_gated_recurrence(to_heads(q, HGRN_HEADS), to_heads(k, HGRN_HEADS),
                               to_heads(i.astype(jnp.float32), HGRN_HEADS),
                               to_heads(jnp.log(f), HGRN_HEADS))
    o = o.transpose(0, 2, 1, 3)
    gate = jax.nn.silu(g.astype(jnp.float32)).reshape(b_, s_, HGRN_HEADS, HGRN_V_HEAD)
    o = rmsnorm(o, gnorm_w) * gate
    return (o.reshape(b_, s_, D_MODEL).astype(h.dtype) @ w_out).astype(h.dtype)


def t5_bucket(rel):
    n = jnp.maximum(rel, 0)
    max_exact = N_BUCKETS // 2
    nf = jnp.maximum(n, 1).astype(jnp.float32)
    large = max_exact + (jnp.log(nf / max_exact) / math.log(MAX_DISTANCE / max_exact)
                         * (N_BUCKETS - max_exact)).astype(jnp.int32)
    large = jnp.minimum(large, N_BUCKETS - 1)
    return jnp.where(n < max_exact, n, large)


def shared_kv(h, kv_norm_w, w_kv):
    kv = rmsnorm(h, kv_norm_w) @ w_kv
    hd = DIFF_HEADS * DIFF_HEAD_DIM
    k1, k2, v = jnp.split(kv, [hd, 2 * hd], axis=-1)
    return (to_heads(k1, DIFF_HEADS), to_heads(k2, DIFF_HEADS), to_heads(v, DIFF_HEADS))


def diff_attention(h, k1, k2, v, w_q, lam_p, subln_w, w_out, rel_bias, lambda_init):
    b_, s_, _ = h.shape
    scale = DIFF_HEAD_DIM ** -0.5
    q1, q2 = jnp.split(h @ w_q, 2, axis=-1)
    nb = s_ // Q_BLOCK

    def blocks(t):
        t = (to_heads(t, DIFF_HEADS) * scale).astype(h.dtype)
        return t.reshape(b_, DIFF_HEADS, nb, Q_BLOCK, DIFF_HEAD_DIM).transpose(2, 0, 1, 3, 4)

    lp = lam_p.astype(jnp.float32)
    lam = jnp.exp(jnp.sum(lp[0] * lp[1])) - jnp.exp(jnp.sum(lp[2] * lp[3])) + lambda_init
    k_pos = jnp.arange(s_, dtype=jnp.int32)
    table = rel_bias.astype(jnp.float32)

    def one_block(args):
        q1c, q2c, blk = args
        q_pos = blk * Q_BLOCK + jnp.arange(Q_BLOCK, dtype=jnp.int32)
        rel = q_pos[:, None] - k_pos[None, :]
        bias = table[t5_bucket(rel)].transpose(2, 0, 1)[None]
        causal = rel >= 0

        def probs(qc, kk):
            sc = jnp.einsum('bhqd,bhkd->bhqk', qc, kk).astype(jnp.float32) + bias
            return jax.nn.softmax(jnp.where(causal, sc, -jnp.inf), axis=-1)

        p = probs(q1c, k1) - lam * probs(q2c, k2)
        return jnp.einsum('bhqk,bhke->bhqe', p.astype(v.dtype), v)

    o = lax.map(one_block, (blocks(q1), blocks(q2), jnp.arange(nb, dtype=jnp.int32)))
    o = o.transpose(1, 0, 3, 2, 4).reshape(b_, s_, DIFF_HEADS, DIFF_V_DIM)
    o = rmsnorm(o, subln_w) * (1.0 - lambda_init)
    return (o.reshape(b_, s_, D_MODEL) @ w_out).astype(h.dtype)


def setup_inputs(seed: int = 0) -> dict:
    key = jax.random.key(seed)
    ks = jax.random.split(key, 16)
    f32 = jnp.float32

    def nrm(k, shape, fan_in):
        return jax.random.normal(k, shape, f32) * fan_in ** -0.5

    def gain(k, shape):
        return 1.0 + 0.02 * jax.random.normal(k, shape, f32)

    return {
        "x": jax.random.normal(ks[0], (BATCH, SEQ, D_MODEL), f32),
        "norm_w": gain(ks[1], (DEPTH, 3, D_MODEL)),
        "ffn_w_in": nrm(ks[2], (DEPTH, 2, D_MODEL, 2 * D_FF), D_MODEL),
        "ffn_w_out": nrm(ks[3], (DEPTH, 2, D_FF, D_MODEL), D_FF),
        "hgrn_w_in": nrm(ks[4], (N_A_LAYERS, D_MODEL, HGRN_IN_DIM), D_MODEL),
        "hgrn_lower_bounds": 0.1 * jax.random.normal(ks[5], (DEPTH, HGRN_F_DIM), f32),
        "hgrn_gnorm_w": gain(ks[6], (N_A_LAYERS, HGRN_V_HEAD)),
        "hgrn_w_out": nrm(ks[7], (N_A_LAYERS, D_MODEL, D_MODEL), D_MODEL),
        "kv_norm_w": gain(ks[8], (D_MODEL,)),
        "w_kv": nrm(ks[9], (D_MODEL, DIFF_KV_DIM), D_MODEL),
        "rel_bias": 0.5 * jax.random.normal(ks[10], (N_BUCKETS, DIFF_HEADS), f32),
        "diff_w_q": nrm(ks[11], (N_B_LAYERS, D_MODEL, DIFF_Q_DIM), D_MODEL),
        "diff_lambda": 0.1 * jax.random.normal(ks[12], (N_B_LAYERS, 4, DIFF_HEAD_DIM), f32),
        "diff_subln_w": gain(ks[13], (N_B_LAYERS, DIFF_V_DIM)),
        "diff_w_out": nrm(ks[14], (N_B_LAYERS, D_MODEL, D_MODEL), D_MODEL),
        "final_norm_w": gain(ks[15], (D_MODEL,)),
    }


def reference(x, norm_w, ffn_w_in, ffn_w_out, hgrn_w_in, hgrn_lower_bounds, hgrn_gnorm_w,
              hgrn_w_out, kv_norm_w, w_kv, rel_bias, diff_w_q, diff_lambda, diff_subln_w,
              diff_w_out, final_norm_w):
    lbs = jnp.cumsum(jax.nn.softmax(hgrn_lower_bounds.astype(jnp.float32), axis=0), axis=0)
    h = x
    k1 = k2 = v = None
    for l in range(DEPTH):
        h = h + FFN_RES * swiglu(rmsnorm(h, norm_w[l, 0]), ffn_w_in[l, 0], ffn_w_out[l, 0])
        hn = rmsnorm(h, norm_w[l, 1])
        if l < N_A_LAYERS:
            h = h + hgrn2_mixer(hn, hgrn_w_in[l], lbs[l], hgrn_gnorm_w[l], hgrn_w_out[l])
        else:
            j = l - N_A_LAYERS
            lambda_init = 0.8 - 0.6 * math.exp(-0.3 * l)
            h = h + diff_attention(hn, k1, k2, v, diff_w_q[j], diff_lambda[j], diff_subln_w[j],
                                   diff_w_out[j], rel_bias, lambda_init)
        h = h + FFN_RES * swiglu(rmsnorm(h, norm_w[l, 2]), ffn_w_in[l, 1], ffn_w_out[l, 1])
        if l == N_A_LAYERS - 1:
            k1, k2, v = shared_kv(h, kv_norm_w, w_kv)
    return rmsnorm(h, final_norm_w)
```

```cpp
#include <hip/hip_runtime.h>
#include <hip/hip_bf16.h>
#include <hip/hip_cooperative_groups.h>
#include <cstdio>
#include <cstdint>
#include <cmath>
namespace cg = cooperative_groups;
__device__ __forceinline__ int fresh_tid(int wave_s) { int l; asm volatile("v_mbcnt_lo_u32_b32 %0, -1, 0\n\tv_mbcnt_hi_u32_b32 %0, -1, %0" : "=v"(l)); return wave_s * 64 + l; }
namespace pg8 {
#define PG8_LAS __attribute__((address_space(3)))
typedef unsigned short bf16_t;
typedef short bf16x8 __attribute__((ext_vector_type(8)));
typedef float f32x4 __attribute__((ext_vector_type(4)));
typedef unsigned u32x4 __attribute__((ext_vector_type(4)));
constexpr int BM = 256, BK = 64, HALF = 128, HTB = HALF * BK * 2  , STAGE_BYTES = 8 * HTB, NXCD = 8, WGM = 8;

__host__ __device__ __forceinline__ int lds_byte(int r, int c) { const int st = (r >> 4) * 2 + (c >> 5), rr = r & 15, cc = c & 31, ob = rr * 64 + cc * 2; return st * 1024 + (ob ^ (((ob >> 9) & 1) << 5)); }
__host__ __device__ __forceinline__ void stage_rc(int b, int& R, int& C) { const int st = b / 1024, sb = b % 1024, swz = sb ^ (((sb >> 9) & 1) << 5); R = (st >> 1) * 16 + swz / 64; C = (st & 1) * 32 + (swz % 64) / 2; }
__host__ __device__ __forceinline__ int perm32(int rho) { const int n = rho >> 4, i = rho & 15; return 8 * (i >> 2) + 4 * n + (i & 3); }

struct Unit { int pm, pn; };
struct Gemm { const bf16_t* A; const bf16_t* Bt; int M, N, K; };

struct StaticOrder {
    int nM, nN, nwg, G, c;
    __host__ __device__ void init(int M, int N, int G_, int c_) { nM = M / BM; nN = N / BM; nwg = nM * nN; G = G_; c = c_; }
    __host__ __device__ bool next(int i, Unit& u) const {
        const long L = (long)i * G + c; if (L >= nwg) return false;
        int wgid = (int)L; { const int q = nwg / NXCD, r = nwg % NXCD, xcd = wgid % NXCD, off = wgid / NXCD; wgid = (xcd < r ? xcd * (q + 1) : r * (q + 1) + (xcd - r) * q) + off; }
        const int nig = WGM * nN, gid = wgid / nig, fm = gid * WGM, gsz = (nM - fm) < WGM ? (nM - fm) : WGM;
        u.pm = fm + ((wgid % nig) % gsz); u.pn = (wgid % nig) / gsz; return true;
    }
    __device__ __forceinline__ void a_ready(const Unit&) const {}
    __device__ __forceinline__ void done(const Unit&) const {}
};

__device__ __forceinline__ unsigned cvt_pk_bf16(float lo, float hi) { unsigned r; asm volatile("v_cvt_pk_bf16_f32 %0, %1, %2" : "=v"(r) : "v"(lo), "v"(hi)); return r; }
typedef float f32x2 __attribute__((ext_vector_type(2)));
template <class Epi, class Sched, bool ALIGN_EPI = false, bool SP2 = false>
__device__ __forceinline__ void gemm_phase(PG8_LAS unsigned char* lds, const Gemm g, const Sched& S, const Epi& E, int wave_s) {
    const int tid = fresh_tid(wave_s), wid = wave_s, lane = tid & 63, wr = wid >> 2, wc = wid & 3, fr = lane & 15, fq = lane >> 4;
    const int K = g.K, nt = K / BK;
    unsigned voffA[2], voffB[2];
#pragma unroll
    for (int i = 0; i < 2; ++i) { int R, C; stage_rc(tid * 16 + i * 8192, R, C); const int Rb = Epi::PERM ? ((R & ~31) + perm32(R & 31)) : R;
        voffA[i] = (unsigned)(R * K + C) * 2u; voffB[i] = (unsigned)(Rb * K + C) * 2u; }
    const size_t kstep = (size_t)(BK * 2);
    const size_t hstep = (size_t)HALF * K * 2;
    const size_t tstep = 2 * hstep;
    const unsigned ldsw = (unsigned)wid * 1024u;
    const int aoff = lds_byte(wr * 64 + fr, fq * 8), boff = lds_byte(wc * 32 + fr, fq * 8);
#define PG8_SA(b, h) (((b) * 2 + (h)) * HTB)
#define PG8_SB(b, h) ((4 + (b) * 2 + (h)) * HTB)
#define PG8_STAGE(bufoff, gbase, voff) do { _Pragma("unroll") for (int _i = 0; _i < 2; ++_i) \
        __builtin_amdgcn_global_load_lds((const unsigned*)((const char*)(gbase) + (voff)[_i]), (PG8_LAS unsigned*)(lds + (bufoff) + ldsw + _i * 8192), 16, 0, 0); } while (0)
#define PG8_LDA(dst, b, h) do { _Pragma("unroll") for (int m = 0; m < 4; ++m) _Pragma("unroll") for (int k = 0; k < 2; ++k) dst[m][k] = *(const PG8_LAS bf16x8*)(lds + PG8_SA(b, h) + aoff + m * 2048 + k * 1024); } while (0)
#define PG8_LDB(dst, b, h) do { _Pragma("unroll") for (int n = 0; n < 2; ++n) _Pragma("unroll") for (int k = 0; k < 2; ++k) dst[n][k] = *(const PG8_LAS bf16x8*)(lds + PG8_SB(b, h) + boff + n * 2048 + k * 1024); } while (0)
#define PG8_MMA(ai, bj, At, Bt) do { __builtin_amdgcn_s_setprio(1); _Pragma("unroll") for (int m = 0; m < 4; ++m) _Pragma("unroll") for (int n = 0; n < 2; ++n) _Pragma("unroll") for (int k = 0; k < 2; ++k) \
        acc[ai][bj][m][n] = __builtin_amdgcn_mfma_f32_16x16x32_bf16(Bt[n][k], At[m][k], acc[ai][bj][m][n], 0, 0, 0); __builtin_amdgcn_s_setprio(0); } while (0)
#define PG8_WAIT_V(n) asm volatile("s_waitcnt vmcnt(" #n ")" ::: "memory")
#define PG8_WAIT_L(n) asm volatile("s_waitcnt lgkmcnt(" #n ")" ::: "memory")
#define PG8_BAR __builtin_amdgcn_s_barrier()
#define PG8_SCHED __builtin_amdgcn_sched_barrier(0)
    Unit cur, nxt; int ui = 0;
    if (!S.next(0, cur)) return;
    f32x4 acc[2][2][4][2];
#pragma unroll
    for (int a = 0; a < 2; ++a)
#pragma unroll
        for (int b = 0; b < 2; ++b)
#pragma unroll
            for (int m = 0; m < 4; ++m)
#pragma unroll
                for (int n = 0; n < 2; ++n) acc[a][b][m][n] = (f32x4){0.f, 0.f, 0.f, 0.f};
    bf16x8 At[4][2], B0[2][2], B1[2][2];
    const char* cA = (const char*)g.A + (size_t)cur.pm * tstep; const char* cB = (const char*)g.Bt + (size_t)cur.pn * tstep;
    S.a_ready(cur);
    if constexpr (SP2) {
        PG8_STAGE(PG8_SB(0, 0), cB, voffB); PG8_STAGE(PG8_SB(0, 1), cB + hstep, voffB); PG8_STAGE(PG8_SA(0, 0), cA, voffA); PG8_STAGE(PG8_SA(0, 1), cA + hstep, voffA);
        if (wr == 1) PG8_BAR;
        PG8_WAIT_V(2); PG8_BAR;
        PG8_STAGE(PG8_SB(1, 0), cB + kstep, voffB); PG8_STAGE(PG8_SA(1, 0), cA + kstep, voffA); PG8_STAGE(PG8_SB(1, 1), cB + hstep + kstep, voffB);
        PG8_WAIT_V(6); PG8_BAR;
    } else {
        PG8_STAGE(PG8_SB(0, 0), cB, voffB); PG8_STAGE(PG8_SA(0, 0), cA, voffA); PG8_STAGE(PG8_SB(0, 1), cB + hstep, voffB); PG8_STAGE(PG8_SA(0, 1), cA + hstep, voffA);
        if (wr == 1) PG8_BAR;
        PG8_WAIT_V(4); PG8_BAR;
        PG8_STAGE(PG8_SB(1, 0), cB + kstep, voffB); PG8_STAGE(PG8_SA(1, 0), cA + kstep, voffA); PG8_STAGE(PG8_SB(1, 1), cB + hstep + kstep, voffB);
        PG8_WAIT_V(6); PG8_BAR;
    }
    for (;;) {
        const bool has_next = S.next(ui + 1, nxt);
        const char* nA = has_next ? (const char*)g.A + (size_t)nxt.pm * tstep : cA; const char* nB = has_next ? (const char*)g.Bt + (size_t)nxt.pn * tstep : cB;
        for (int t = 0; t < nt; t += 2) {
            const bool last = (t == nt - 2);
            const char* a1 = cA + (size_t)(t + 1) * kstep;
            const char* a2 = last ? nA : cA + (size_t)(t + 2) * kstep; const char* b2 = last ? nB : cB + (size_t)(t + 2) * kstep;
            const char* a3 = a2 + kstep; const char* b3 = b2 + kstep;
            if (last && has_next) S.a_ready(nxt);
            if constexpr (SP2) {
            PG8_LDB(B0, 0, 0); PG8_LDB(B1, 0, 1); PG8_SCHED; PG8_LDA(At, 0, 0); PG8_STAGE(PG8_SA(1, 1), a1 + hstep, voffA);
            PG8_WAIT_V(8); PG8_WAIT_L(0); PG8_BAR; PG8_MMA(0, 0, At, B0); PG8_MMA(0, 1, At, B1); PG8_BAR; PG8_SCHED;
            PG8_LDA(At, 0, 1); PG8_STAGE(PG8_SB(0, 0), b2, voffB); PG8_STAGE(PG8_SB(0, 1), b2 + hstep, voffB); PG8_STAGE(PG8_SA(0, 0), a2, voffA);
            PG8_WAIT_V(8); PG8_WAIT_L(0); PG8_BAR; PG8_MMA(1, 0, At, B0); PG8_MMA(1, 1, At, B1); PG8_BAR; PG8_SCHED;
            PG8_LDB(B0, 1, 0); PG8_LDB(B1, 1, 1); PG8_SCHED; PG8_LDA(At, 1, 0); PG8_STAGE(PG8_SA(0, 1), a2 + hstep, voffA);
            PG8_WAIT_V(8); PG8_WAIT_L(0); PG8_BAR; PG8_MMA(0, 0, At, B0); PG8_MMA(0, 1, At, B1); PG8_BAR; PG8_SCHED;
            PG8_LDA(At, 1, 1); PG8_STAGE(PG8_SB(1, 0), b3, voffB); PG8_STAGE(PG8_SB(1, 1), b3 + hstep, voffB); PG8_STAGE(PG8_SA(1, 0), a3, voffA);
            PG8_WAIT_V(8); PG8_WAIT_L(0); PG8_BAR; PG8_MMA(1, 0, At, B0); PG8_MMA(1, 1, At, B1); PG8_BAR; PG8_SCHED;
            } else {
            PG8_LDB(B0, 0, 0); PG8_SCHED; PG8_LDA(At, 0, 0); PG8_STAGE(PG8_SA(1, 1), a1 + hstep, voffA);
            PG8_WAIT_L(8); PG8_BAR; PG8_WAIT_L(0); PG8_MMA(0, 0, At, B0); PG8_BAR; PG8_SCHED;
            PG8_LDB(B1, 0, 1); PG8_STAGE(PG8_SB(0, 0), b2, voffB);
            PG8_BAR; PG8_WAIT_L(0); PG8_MMA(0, 1, At, B1); PG8_BAR;
            PG8_LDA(At, 0, 1); PG8_STAGE(PG8_SA(0, 0), a2, voffA);
            PG8_BAR; PG8_WAIT_L(0); PG8_MMA(1, 0, At, B0); PG8_BAR; PG8_SCHED;
            PG8_STAGE(PG8_SB(0, 1), b2 + hstep, voffB);
            PG8_WAIT_V(6); PG8_BAR; PG8_MMA(1, 1, At, B1); PG8_BAR;
            PG8_LDB(B0, 1, 0); PG8_SCHED; PG8_LDA(At, 1, 0); PG8_STAGE(PG8_SA(0, 1), a2 + hstep, voffA);
            PG8_WAIT_L(8); PG8_BAR; PG8_WAIT_L(0); PG8_MMA(0, 0, At, B0); PG8_BAR; PG8_SCHED;
            PG8_LDB(B1, 1, 1); PG8_STAGE(PG8_SB(1, 0), b3, voffB);
            PG8_BAR; PG8_WAIT_L(0); PG8_MMA(0, 1, At, B1); PG8_BAR;
            PG8_LDA(At, 1, 1); PG8_STAGE(PG8_SA(1, 0), a3, voffA);
            PG8_BAR; PG8_WAIT_L(0); PG8_MMA(1, 0, At, B0); PG8_BAR; PG8_SCHED;
            PG8_STAGE(PG8_SB(1, 1), b3 + hstep, voffB);
            PG8_WAIT_V(6); PG8_BAR; PG8_MMA(1, 1, At, B1); PG8_BAR;
            }
        }
        if constexpr (ALIGN_EPI) { if (wr == 0) PG8_BAR; }
        if constexpr (!Epi::AFTER_DRAIN) { E(acc, cur, wr, wc, fr, fq); S.done(cur); }
        if (!has_next) break;
#pragma unroll
        for (int a = 0; a < 2; ++a)
#pragma unroll
            for (int b = 0; b < 2; ++b)
#pragma unroll
                for (int m = 0; m < 4; ++m)
#pragma unroll
                    for (int n = 0; n < 2; ++n) acc[a][b][m][n] = (f32x4){0.f, 0.f, 0.f, 0.f};
        cur = nxt; cA = nA; cB = nB; ++ui;
        if constexpr (ALIGN_EPI) { if (wr == 1) PG8_BAR; }
    }
    PG8_WAIT_V(0);
    if constexpr (!ALIGN_EPI) { if (wr == 0) PG8_BAR; }
    PG8_BAR;
    if constexpr (Epi::AFTER_DRAIN) { E.fused(acc, cur, wr, wc, fr, fq, lds, wid, lane); S.done(cur); }
#undef PG8_SA
#undef PG8_SB
#undef PG8_STAGE
#undef PG8_LDA
#undef PG8_LDB
#undef PG8_MMA
#undef PG8_WAIT_V
#undef PG8_WAIT_L
#undef PG8_BAR
#undef PG8_SCHED
}
}
#include <hip/hip_bf16.h>
namespace attn_body {
using bf16=__hip_bfloat16;
using bf16x8=__attribute__((ext_vector_type(8)))short;
using s16x4=__attribute__((ext_vector_type(4)))short;
using f32x16=__attribute__((ext_vector_type(16)))float;
using u32x4=__attribute__((ext_vector_type(4)))unsigned;
constexpr int BATCH=4,NHEAD=32,SEQ=8192,D=64,QP=1024,KP=2048,VP=2048,OP=2048;
constexpr int NW=8,QBLK=32,QB=QBLK*NW,KVBLK=64,NQB=SEQ/QB;
constexpr int ATTN_UNIT_ROWS=QB;
__device__ __forceinline__ int crow(int r,int hi){return (r&3)+8*(r>>2)+4*hi;}
#define SBAR() __builtin_amdgcn_sched_barrier(0)
__device__ __forceinline__ void cmask(f32x16&p0,f32x16&p1,int jb,int qrel,int hi){
  const float NEG=-INFINITY; int kb=64*jb+4*hi;
  #pragma unroll
  for(int r=0;r<16;++r){int kv=kb+(r&3)+8*(r>>2); if(kv>qrel)p0[r]=NEG; if(kv+32>qrel)p1[r]=NEG;}
}

__device__ __forceinline__ void addbias(f32x16&p0,f32x16&p1,const __attribute__((address_space(3))) float* tb){
  #pragma unroll
  for(int r=0;r<16;++r){ p0[r]+=tb[-((r&3)+8*(r>>2))]; p1[r]+=tb[-((r&3)+8*(r>>2))-32]; }
}
constexpr int NSLOT=3, SLOTB=8192;
constexpr int LDS_K=0, LDS_V=NSLOT*SLOTB, LDS_WS=2*NSLOT*SLOTB, LDS_OST=LDS_WS+NW*64*4, LDS_BYTES=LDS_OST+NW*4096;
constexpr float C2=0.125f*1.4426950408889634f;
__device__ __forceinline__ void glds16(const void*gsrc,unsigned lds_dst){unsigned keep;
  asm volatile("s_mov_b32 %0, m0\n\ts_mov_b32 m0, %2\n\ts_nop 0\n\tglobal_load_lds_dwordx4 %1, off\n\ts_mov_b32 m0, %0":"=&s"(keep):"v"(gsrc),"s"(lds_dst):"memory");}
__device__ __forceinline__ float max3f(float a,float b,float c){float r;asm("v_max3_f32 %0, %1, %2, %3":"=v"(r):"v"(a),"v"(b),"v"(c));return r;}
__device__ __forceinline__ float max2f(float a,float b){float r;asm("v_max_f32_e32 %0, %1, %2":"=v"(r):"v"(a),"v"(b));return r;}
__device__ __forceinline__ float fadd_s(float a,float b){float r;asm("v_add_f32_e32 %0, %1, %2":"=v"(r):"v"(a),"v"(b));return r;}
__device__ __forceinline__ float fsub_s(float a,float b){float r;asm("v_sub_f32_e32 %0, %1, %2":"=v"(r):"v"(a),"v"(b));return r;}
typedef float f32x2_t __attribute__((ext_vector_type(2))); typedef __bf16 bf16x2_t __attribute__((ext_vector_type(2)));
__device__ __forceinline__ unsigned cvtpk_s(float lo,float hi){f32x2_t v={lo,hi};bf16x2_t b=__builtin_convertvector(v,bf16x2_t);return __builtin_bit_cast(unsigned,b);}
#define WAIT_BAR(N) asm volatile("s_waitcnt vmcnt(" #N ") lgkmcnt(0)\n\ts_barrier":::"memory")

__device__ __forceinline__ void qkt(f32x16&p0,f32x16&p1,const char*Kslot,const bf16x8*qr,int r32,int hi){ const f32x16 negm=f32x16{};
  const char*kb=Kslot+hi*1024+r32*16;
  #pragma unroll
  for(int d0=0;d0<4;++d0){
    const bf16x8 b0=*reinterpret_cast<const bf16x8*>(kb+d0*2048);
    const bf16x8 b1=*reinterpret_cast<const bf16x8*>(kb+d0*2048+512);
    if(d0==0){p0=__builtin_amdgcn_mfma_f32_32x32x16_bf16(b0,qr[0],negm,0,0,0);p1=__builtin_amdgcn_mfma_f32_32x32x16_bf16(b1,qr[0],negm,0,0,0);}
    else{p0=__builtin_amdgcn_mfma_f32_32x32x16_bf16(b0,qr[d0],p0,0,0,0);p1=__builtin_amdgcn_mfma_f32_32x32x16_bf16(b1,qr[d0],p1,0,0,0);}}
}
typedef __attribute__((address_space(3))) const char* lds_cptr;
typedef short v4i16_t __attribute__((ext_vector_type(4)));
__device__ __forceinline__ void kload8(bf16x8*kf,lds_cptr kp){
  kf[0]=*(const __attribute__((address_space(3))) bf16x8*)(kp);      kf[1]=*(const __attribute__((address_space(3))) bf16x8*)(kp+512);
  kf[2]=*(const __attribute__((address_space(3))) bf16x8*)(kp+2048); kf[3]=*(const __attribute__((address_space(3))) bf16x8*)(kp+2560);
  kf[4]=*(const __attribute__((address_space(3))) bf16x8*)(kp+4096); kf[5]=*(const __attribute__((address_space(3))) bf16x8*)(kp+4608);
  kf[6]=*(const __attribute__((address_space(3))) bf16x8*)(kp+6144); kf[7]=*(const __attribute__((address_space(3))) bf16x8*)(kp+6656);
}
__device__ __forceinline__ void kload2(bf16x8*kf,lds_cptr kp,int j){ kf[2*j]=*(const __attribute__((address_space(3))) bf16x8*)(kp+j*2048); kf[2*j+1]=*(const __attribute__((address_space(3))) bf16x8*)(kp+j*2048+512); }
__device__ __forceinline__ s16x4 vtr(lds_cptr p){ return __builtin_bit_cast(s16x4,__builtin_amdgcn_ds_read_tr16_b64_v4i16((__attribute__((address_space(3))) v4i16_t*)p)); }
__device__ __forceinline__ float rowmax(const f32x16&p0,const f32x16&p1){
  float a=max3f(p0[0],p0[1],p1[0]),b=max3f(p0[2],p0[3],p1[1]);a=max3f(a,p1[2],p1[3]);
  #pragma unroll
  for(int r=4;r<16;r+=4){a=max3f(a,p0[r],p0[r+1]);b=max3f(b,p0[r+2],p0[r+3]);a=max3f(a,p1[r],p1[r+1]);b=max3f(b,p1[r+2],p1[r+3]);}
  const float m=max2f(a,b);
  auto rr=__builtin_amdgcn_permlane32_swap(__float_as_uint(m),__float_as_uint(m),false,false);
  return max2f(__uint_as_float(rr[0]),__uint_as_float(rr[1]));
}
__device__ __forceinline__ void pv(f32x16*o,int vb,bf16x8 pa0,bf16x8 pa1,bf16x8 pa2,bf16x8 pa3){
  #pragma unroll
  for(int d0=0;d0<2;++d0){s16x4 lo[4],hi[4];
    #pragma unroll
    for(int ks=0;ks<4;++ks){
      asm volatile("ds_read_b64_tr_b16 %0,%1 offset:%c2":"=&v"(lo[ks]):"v"(vb),"i"(d0*4096+ks*1024):"memory");
      asm volatile("ds_read_b64_tr_b16 %0,%1 offset:%c2":"=&v"(hi[ks]):"v"(vb),"i"(d0*4096+ks*1024+512):"memory");}
    asm volatile("s_waitcnt lgkmcnt(0)":::"memory");SBAR();
    #define PK(k) (bf16x8){lo[k][0],lo[k][1],lo[k][2],lo[k][3],hi[k][0],hi[k][1],hi[k][2],hi[k][3]}
    o[d0]=__builtin_amdgcn_mfma_f32_32x32x16_bf16(pa0,PK(0),o[d0],0,0,0);
    o[d0]=__builtin_amdgcn_mfma_f32_32x32x16_bf16(pa1,PK(1),o[d0],0,0,0);
    o[d0]=__builtin_amdgcn_mfma_f32_32x32x16_bf16(pa2,PK(2),o[d0],0,0,0);
    o[d0]=__builtin_amdgcn_mfma_f32_32x32x16_bf16(pa3,PK(3),o[d0],0,0,0);
    #undef PK
  }
}

#ifndef ATTN_STORE16
#define ATTN_STORE16(p,v) (*(u32x4*)(p)=(v))
#endif
template<int THRL> __device__ __forceinline__ void attn_unit(int b,int vh,int qb,const bf16*Q,const bf16*__restrict__ K,const bf16*__restrict__ V,bf16*O,const float*btab,char*shm,int wave_s){
  const int h=vh>>2,jm=(vh>>1)&1,cv=vh&1;
  const int tid=fresh_tid(wave_s),lane=tid&63,r32=lane&31,hi=lane>>5; const int wid=wave_s;
  const long rowbase=(long)b*SEQ; const int q0=qb*QB;
  const bf16*Qw=Q+(rowbase+q0+wid*QBLK)*QP+jm*512+h*64;
  const bf16*Kh=K+rowbase*KP+jm*512+h*64,*Vh=V+rowbase*VP+1024+h*128+cv*64;
  const unsigned lds0=(unsigned)(uintptr_t)shm;
  float*wsf=(float*)(shm+LDS_WS)+wid*64;
  const bf16*ksrc=Kh+(long)lane*KP+wid*8;
  const bf16*vsrc=Vh+(long)(16*(wid&3)+(lane>>2))*VP+(wid>>2)*32+(lane&3)*8;
  const unsigned kdst=lds0+LDS_K+wid*1024, vdst=lds0+LDS_V+wid*1024;
  #define DMA_K(t,slot) glds16(ksrc+(long)(t)*KVBLK*KP,(unsigned)__builtin_amdgcn_readfirstlane(kdst+(slot)))
  #define DMA_V(t,slot) glds16(vsrc+(long)(t)*KVBLK*VP,(unsigned)__builtin_amdgcn_readfirstlane(vdst+(slot)))
  const int vb0=(int)(lds0+LDS_V)+((lane>>4)&1)*32+(lane&3)*8+(4*hi+((lane&15)>>2))*64;
  const char*Kbase=shm+LDS_K; bf16x8 kf[8];
  const lds_cptr shm3=(lds_cptr)shm; const lds_cptr kp0=shm3+LDS_K+hi*1024+r32*16; const lds_cptr vp0=shm3+LDS_V+((lane>>4)&1)*32+(lane&3)*8+(4*hi+((lane&15)>>2))*64;
  const __attribute__((address_space(3))) float* tabL=(const __attribute__((address_space(3))) float*)(shm3+LDS_BYTES);
  { __attribute__((address_space(3))) float* tw=(__attribute__((address_space(3))) float*)(shm3+LDS_BYTES); const int d_=tid-256; tw[tid]=(d_>=0&&d_<128)?btab[h*128+d_]:0.f; if(tid<256)tw[512+tid]=0.f; }
  const int NT=(q0+QB)/KVBLK;
  DMA_K(0,0);DMA_V(0,0);DMA_K(1,SLOTB);
  bf16x8 qr[4];
  #pragma unroll
  for(int d0=0;d0<4;++d0)qr[d0]=*reinterpret_cast<const bf16x8*>(&Qw[(long)r32*QP+d0*16+hi*8]);
  float mhat=0.f,l_reg=0.f;f32x16 o[2];o[0]=f32x16{};o[1]=f32x16{};
  const int qrel=wid*QBLK+r32;
  #define CMASK(P0,P1,t) do{ if((t)>=NT-6) addbias(P0,P1,tabL+(256+q0+qrel-64*(t)-4*hi)); int jb_=(t)-(NT-4); if(jb_>=0)cmask(P0,P1,jb_,qrel,hi);}while(0)
  bool resc=false;
  #define START(P0,P1) do{ const float rm=rowmax(P0,P1); resc=false; \
    { const float dl=rm; mhat=fadd_s(mhat,dl); \
      _Pragma("unroll") for(int r=0;r<16;++r){P0[r]=fsub_s(P0[r],dl);P1[r]=fsub_s(P1[r],dl);} \
      } \
    _Pragma("unroll") for(int r=0;r<16;++r)P0[r]=__builtin_amdgcn_exp2f(P0[r]); }while(0)
  #define RESC() do{ if(resc){ asm volatile("s_waitcnt lgkmcnt(0)":::"memory"); \
      _Pragma("unroll") for(int d_=0;d_<2;++d_) _Pragma("unroll") for(int r=0;r<16;++r)o[d_][r]*=wsf[crow(r,hi)]; } }while(0)
  f32x16 pA0,pA1,pB0,pB1;
  int sl_prev=0,sl_cur=0,sl_next=SLOTB;
  #define ROT() do{sl_prev=sl_cur;sl_cur=sl_next;sl_next=(sl_next==(NSLOT-1)*SLOTB)?0:sl_next+SLOTB;}while(0)
  DMA_K(2,2*SLOTB);
  WAIT_BAR(3);
  qkt(pA0,pA1,Kbase,qr,r32,hi);asm volatile("s_nop 15\n\ts_nop 7":"+v"(pA0),"+v"(pA1));CMASK(pA0,pA1,0);
  START(pA0,pA1);
  _Pragma("unroll") for(int r=0;r<16;++r)pA1[r]=__builtin_amdgcn_exp2f(pA1[r]);
  WAIT_BAR(0);
  DMA_K(3,0);DMA_V(1,SLOTB);
  ROT();
  kload8(kf,kp0+sl_cur);
  WAIT_BAR(2);
  s16x4 vlo[8],vhi[8]; u32x4 pw0,pw1,pw2,pw3;
  #define PKW(P,B) cvtpk_s(P[B],P[B+1])
  #define PAF(k) __builtin_bit_cast(bf16x8,pw##k)
  #define VFR(i) (bf16x8){vlo[i][0],vlo[i][1],vlo[i][2],vlo[i][3],vhi[i][0],vhi[i][1],vhi[i][2],vhi[i][3]}
  #define PIN(x) asm volatile("":"+v"(x))
  #define MX3(a,b,c) __builtin_fmaxf(__builtin_fmaxf((a),(b)),(c))
  #define GAPA(MF,A0,A1,A2,A3,W0,W1,PW) do{ MF; sacc+=A0; sacc+=A1; sacc+=A2; sacc+=A3; PIN(sacc); W0; W1; PIN(PW); SBAR(); }while(0)
  #define EX(v) __builtin_amdgcn_exp2f(v)
  #define GAPB(MF,X,B) do{ MF; X[B]=EX(X[B]); X[B+1]=EX(X[B+1]); X[B+2]=EX(X[B+2]); X[B+3]=EX(X[B+3]); PIN(X); SBAR(); }while(0)
  #define VRD(i) do{ vlo[i]=vtr(vp_+(((i)>>2)*4096+((i)&3)*1024)); vhi[i]=vtr(vp_+(((i)>>2)*4096+((i)&3)*1024+512)); }while(0)
  #define KRD(G,j) do{ if(G){ kload2(kf,kp0+sl_next,j); SBAR(); } }while(0)
  #define STEP(C0,C1,P0,P1,t,GK,GV,GL) do{ SBAR(); \
    const lds_cptr vp_=vp0+sl_prev; \
    VRD(0); SBAR(); float sacc=(P0[0]+P0[1]); \
    GAPA(C0=__builtin_amdgcn_mfma_f32_32x32x16_bf16(kf[0],qr[0],f32x16{},0,0,0), P0[2],P0[3],P0[4],P0[5],     pw0[0]=PKW(P0,0), pw0[1]=PKW(P0,2), pw0); \
    VRD(4); SBAR(); GAPA(C1=__builtin_amdgcn_mfma_f32_32x32x16_bf16(kf[1],qr[0],f32x16{},0,0,0), P0[6],P0[7],P0[8],P0[9],     pw0[2]=PKW(P0,4), pw0[3]=PKW(P0,6), pw0); \
    VRD(1); SBAR(); GAPA(C0=__builtin_amdgcn_mfma_f32_32x32x16_bf16(kf[2],qr[1],C0,0,0,0),   P0[10],P0[11],P0[12],P0[13], pw1[0]=PKW(P0,8), pw1[1]=PKW(P0,10), pw1); \
    VRD(5); SBAR(); GAPA(C1=__builtin_amdgcn_mfma_f32_32x32x16_bf16(kf[3],qr[1],C1,0,0,0),   P0[14],P0[15],P1[0],P1[1],   pw1[2]=PKW(P0,12),pw1[3]=PKW(P0,14), pw1); \
    VRD(2); SBAR(); GAPA(C0=__builtin_amdgcn_mfma_f32_32x32x16_bf16(kf[4],qr[2],C0,0,0,0),   P1[2],P1[3],P1[4],P1[5],     pw2[0]=PKW(P1,0), pw2[1]=PKW(P1,2), pw2); \
    VRD(6); SBAR(); GAPA(C1=__builtin_amdgcn_mfma_f32_32x32x16_bf16(kf[5],qr[2],C1,0,0,0),   P1[6],P1[7],P1[8],P1[9],     pw2[2]=PKW(P1,4), pw2[3]=PKW(P1,6), pw2); \
    VRD(3); SBAR(); GAPA(C0=__builtin_amdgcn_mfma_f32_32x32x16_bf16(kf[6],qr[3],C0,0,0,0),   P1[10],P1[11],P1[12],P1[13], pw3[0]=PKW(P1,8), pw3[1]=PKW(P1,10), pw3); \
    VRD(7); SBAR(); GAPA(C1=__builtin_amdgcn_mfma_f32_32x32x16_bf16(kf[7],qr[3],C1,0,0,0),   P1[14],P1[15],0.f,0.f,       pw3[2]=PKW(P1,12),pw3[3]=PKW(P1,14), pw3); \
    l_reg+=sacc; \
    if(GK){DMA_K((t)+3,sl_cur);} if(GV){DMA_V((t)+1,sl_next);} \
    _Pragma("unroll") for(int r=0;r<16;++r){C0[r]-=mhat;C1[r]-=mhat;} \
    CMASK(C0,C1,t); \
    { float a=MX3(C0[0],C0[1],C1[0]),b=MX3(C0[2],C0[3],C1[1]); a=MX3(a,C1[2],C1[3]); \
      _Pragma("unroll") for(int r=4;r<16;r+=4){a=MX3(a,C0[r],C0[r+1]);b=MX3(b,C0[r+2],C0[r+3]);a=MX3(a,C1[r],C1[r+1]);b=MX3(b,C1[r+2],C1[r+3]);} \
      float rm=__builtin_fmaxf(a,b); { auto rr=__builtin_amdgcn_permlane32_swap(__float_as_uint(rm),__float_as_uint(rm),false,false); rm=__builtin_fmaxf(__uint_as_float(rr[0]),__uint_as_float(rr[1])); } \
      resc=false; \
      if(__builtin_expect(__any(rm>(float)THRL),0)){ const float dl=__builtin_fmaxf(rm,0.f); mhat+=dl; \
        _Pragma("unroll") for(int r=0;r<16;++r){C0[r]-=dl;C1[r]-=dl;} \
        const float f=__builtin_amdgcn_exp2f(-dl); l_reg*=f; if(hi==0)wsf[r32]=f; resc=true; } } \
    SBAR(); \
    GAPB(o[0]=__builtin_amdgcn_mfma_f32_32x32x16_bf16(PAF(0),VFR(0),o[0],0,0,0), C0,0); \
    GAPB(o[1]=__builtin_amdgcn_mfma_f32_32x32x16_bf16(PAF(0),VFR(4),o[1],0,0,0), C0,4); \
    KRD(GL,0); GAPB(o[0]=__builtin_amdgcn_mfma_f32_32x32x16_bf16(PAF(1),VFR(1),o[0],0,0,0), C0,8); \
    KRD(GL,1); GAPB(o[1]=__builtin_amdgcn_mfma_f32_32x32x16_bf16(PAF(1),VFR(5),o[1],0,0,0), C0,12); \
    KRD(GL,2); GAPB(o[0]=__builtin_amdgcn_mfma_f32_32x32x16_bf16(PAF(2),VFR(2),o[0],0,0,0), C1,0); \
    KRD(GL,3); GAPB(o[1]=__builtin_amdgcn_mfma_f32_32x32x16_bf16(PAF(2),VFR(6),o[1],0,0,0), C1,4); \
    GAPB(o[0]=__builtin_amdgcn_mfma_f32_32x32x16_bf16(PAF(3),VFR(3),o[0],0,0,0), C1,8); \
    GAPB(o[1]=__builtin_amdgcn_mfma_f32_32x32x16_bf16(PAF(3),VFR(7),o[1],0,0,0), C1,12); \
    }while(0)
  int t=1;
  #undef CMASK
  #define CMASK(P0,P1,t) do{}while(0)
  for(;t+7<NT;t+=2){
    STEP(pB0,pB1,pA0,pA1,t,true,true,true);     WAIT_BAR(2); RESC(); ROT();
    STEP(pA0,pA1,pB0,pB1,t+1,true,true,true);   WAIT_BAR(2); RESC(); ROT();
  }
  #undef CMASK
  #define CMASK(P0,P1,t) do{ if((t)>=NT-6) addbias(P0,P1,tabL+(256+q0+qrel-64*(t)-4*hi)); int jb_=(t)-(NT-4); if(jb_>=0)cmask(P0,P1,jb_,qrel,hi);}while(0)
  #define ENDW(tt) do{ if((tt)+3<NT){WAIT_BAR(2);} else if((tt)+2<NT){WAIT_BAR(1);} else {WAIT_BAR(0);} }while(0)
  for(;t+1<NT;t+=2){
    STEP(pB0,pB1,pA0,pA1,t,(t+3<NT),(t+1<NT),(t+1<NT));       ENDW(t);   RESC(); ROT();
    STEP(pA0,pA1,pB0,pB1,t+1,(t+4<NT),(t+2<NT),(t+2<NT));     ENDW(t+1); RESC(); ROT();
  }
  STEP(pB0,pB1,pA0,pA1,NT-1,false,false,false); RESC();
  { float sacc=pB0[0]+pB0[1]; _Pragma("unroll") for(int r=2;r<16;++r)sacc+=pB0[r]; _Pragma("unroll") for(int r=0;r<16;++r)sacc+=pB1[r]; l_reg+=sacc;
    pw0=(u32x4){PKW(pB0,0),PKW(pB0,2),PKW(pB0,4),PKW(pB0,6)};pw1=(u32x4){PKW(pB0,8),PKW(pB0,10),PKW(pB0,12),PKW(pB0,14)};pw2=(u32x4){PKW(pB1,0),PKW(pB1,2),PKW(pB1,4),PKW(pB1,6)};pw3=(u32x4){PKW(pB1,8),PKW(pB1,10),PKW(pB1,12),PKW(pB1,14)};
    SBAR(); pv(o,vb0+sl_cur,PAF(0),PAF(1),PAF(2),PAF(3)); }
  #undef PKW
  #undef PAF
  #undef VFR
  #undef PIN
  #undef MX3
  #undef GAPA
  #undef GAPB
  #undef EX
  #undef VRD
  #undef KRD
  #undef STEP
  #undef ENDW
  {auto rr=__builtin_amdgcn_permlane32_swap(__float_as_uint(l_reg),__float_as_uint(l_reg),false,false);l_reg=__uint_as_float(rr[0])+__uint_as_float(rr[1]);}
  if(hi==0)wsf[32+r32]=l_reg;asm volatile("s_waitcnt lgkmcnt(0)":::"memory");
  float rli[16];
  #pragma unroll
  for(int r=0;r<16;++r)rli[r]=__builtin_amdgcn_rcpf(wsf[32+crow(r,hi)]);
  bf16*Ow=O+(rowbase+q0+wid*QBLK)*OP+jm*1024+h*128+cv*64;
  { bf16*stg=(bf16*)(shm+LDS_OST)+wid*2048;
    #pragma unroll
    for(int r=0;r<16;++r){const int orow=crow(r,hi);
      #pragma unroll
      for(int d0=0;d0<2;++d0)stg[orow*64+d0*32+r32]=__float2bfloat16(o[d0][r]*rli[r]);}
    asm volatile("s_waitcnt lgkmcnt(0)":::"memory");
    #pragma unroll
    for(int i=0;i<4;++i){const int row=i*8+(lane>>3),ch=lane&7; const u32x4 v=*(const u32x4*)(stg+row*64+ch*8); ATTN_STORE16(Ow+(long)row*OP+ch*8,v);} }
  asm volatile("s_waitcnt lgkmcnt(0)\n\ts_barrier":::"memory");
  #undef DMA_K
  #undef DMA_V
  #undef CMASK
  #undef START
  #undef RESC
  #undef ROT
}
constexpr int ATTN_LDS_BYTES=LDS_BYTES;
struct AttnTensors { const bf16* Q; const bf16* K; const bf16* V; bf16* O; const float* btab; };
struct AttnUnit { int bh; int qb; };
struct StaticOrder {
  int vcu;
  __device__ __forceinline__ explicit StaticOrder(int grid,int block):vcu((block%8)*(grid/8)+block/8){}
  __device__ __forceinline__ bool next(int i,AttnUnit&u)const{ if(i>=16)return false; const int s=vcu&7,ii=i&3; u.bh=(vcu>>3)+32*(i>>2); u.qb=(ii==0)?s:(ii==1)?15-s:(ii==2)?16+s:31-s; return true; }
  __device__ __forceinline__ void a_ready(const AttnUnit&)const{}
  __device__ __forceinline__ void done(const AttnUnit&)const{}
};
template<class Sched,int THRL=8> __device__ __forceinline__ void attn_phase(char*lds,const AttnTensors&T,const Sched&S,int wave_s){
  AttnUnit u;
  for(int i=0;S.next(i,u);++i){ S.a_ready(u); attn_unit<THRL>(u.bh/NHEAD,u.bh%NHEAD,u.qb,T.Q,T.K,T.V,T.O,T.btab,lds,wave_s); S.done(u); }
}
#undef SBAR
#undef WAIT_BAR
}
#define LAS __attribute__((address_space(3)))
typedef unsigned short bf16_t;
typedef short bf16x8 __attribute__((ext_vector_type(8)));
typedef float f32x4 __attribute__((ext_vector_type(4)));
typedef float f32x16 __attribute__((ext_vector_type(16)));
typedef unsigned u32x4 __attribute__((ext_vector_type(4)));
typedef unsigned u32x2 __attribute__((ext_vector_type(2)));
typedef float f32x2_t __attribute__((ext_vector_type(2)));
typedef __bf16 bf16x2_t __attribute__((ext_vector_type(2)));

constexpr int BATCH = 4, SEQ = 8192, DM = 1024, MTOK = BATCH * SEQ, DFF = 2816, NFF = 2 * DFF;
constexpr float EPS = 1e-6f, LOG2E = 1.4426950408889634f;
constexpr float LAMBDA_INIT = 0.35550906f;
constexpr float QSCALE = 0.125f * LOG2E;
constexpr int NWAVES = 8, NTHR = 512;
constexpr int LDS_BYTES = 139264;

constexpr size_t MiB = 1u << 20;
constexpr size_t WS_SSQ = 0;
constexpr size_t WS_LB = 1 * MiB;
constexpr size_t WS_BTAB = 1 * MiB + 4096;
constexpr size_t WS_LAM = 1 * MiB + 8192;
constexpr size_t WS_FI00 = 2 * MiB, WS_FI01 = 13 * MiB, WS_FO00 = 24 * MiB, WS_FO01 = 24 * MiB + 5632 * 1024, WS_HIN = 35 * MiB, WS_HOUT = 43 * MiB;
constexpr size_t WS_HB = 45 * MiB;
constexpr size_t WS_BIG = 109 * MiB;
constexpr size_t WS_HID = WS_BIG;
constexpr size_t WS_QH = WS_BIG, WS_LF = WS_BIG + 64 * MiB, WS_VH = WS_BIG + 128 * MiB, WS_GH = WS_BIG + 192 * MiB, WS_UT = WS_BIG + 256 * MiB, WS_DEC = WS_BIG + 384 * MiB;
constexpr size_t WS_W1 = 302 * MiB;
constexpr size_t WS_FI10 = WS_W1, WS_FI11 = WS_W1 + 11 * MiB, WS_FO10 = WS_W1 + 22 * MiB, WS_FO11 = WS_W1 + 22 * MiB + 5632 * 1024, WS_WKV = WS_W1 + 33 * MiB, WS_WQ = WS_W1 + 37 * MiB, WS_WAO = WS_W1 + 39 * MiB;
constexpr size_t WS_KV = 361 * MiB;
constexpr size_t WS_QB = WS_BIG;
constexpr size_t WS_OB = WS_BIG + 64 * MiB;
constexpr size_t WS_END = 496 * MiB;
static_assert(WS_DEC + 2 * MiB <= WS_END && WS_KV + 128 * MiB <= WS_END && WS_OB + 128 * MiB <= WS_W1 && WS_WAO + 2 * MiB <= WS_KV && WS_HID + (size_t)MTOK * DFF * 2 <= WS_W1, "ws map");

__device__ __forceinline__ float bf2f(unsigned short b) { return __uint_as_float((unsigned)b << 16); }
__device__ __forceinline__ unsigned pkbf(float lo, float hi) { f32x2_t v = {lo, hi}; bf16x2_t b = __builtin_convertvector(v, bf16x2_t); return __builtin_bit_cast(unsigned, b); }
__device__ __forceinline__ unsigned short f2bf(float f) { return (unsigned short)(pkbf(f, 0.f) & 0xffffu); }
__device__ __forceinline__ float fexp(float x) { return __builtin_amdgcn_exp2f(x * LOG2E); }
__device__ __forceinline__ float sigm(float v) { return __builtin_amdgcn_rcpf(1.f + __builtin_amdgcn_exp2f(-v * LOG2E)); }
__device__ __forceinline__ float silu(float v) { return v * sigm(v); }
__device__ __forceinline__ float wave_sum(float v) {
#pragma unroll
    for (int o = 1; o < 64; o <<= 1) v += __shfl_xor(v, o);
    return v;
}
__device__ __forceinline__ int crow(int r, int hi) { return (r & 3) + 8 * (r >> 2) + 4 * hi; }

namespace epi {
using pg8::Unit;
__device__ __forceinline__ float rstd_of(const float* ssq, int row) { return rsqrtf(ssq[row] * (1.f / 1024.f) + EPS); }

struct EpiSwiglu {
    static constexpr bool PERM = true, AFTER_DRAIN = false;
    bf16_t* H; const float* ssq;
    __device__ __forceinline__ void operator()(const f32x4 (&acc)[2][2][4][2], const Unit& u, int wr, int wc, int fr, int fq) const {
        const int col0 = u.pn * 128 + wc * 32 + 8 * fq;
#pragma unroll
        for (int ai = 0; ai < 2; ++ai)
#pragma unroll
            for (int m = 0; m < 4; ++m) {
                const int row = u.pm * 256 + ai * 128 + wr * 64 + m * 16 + fr; const float r = rstd_of(ssq, row);
                float o[8];
#pragma unroll
                for (int n = 0; n < 2; ++n)
#pragma unroll
                    for (int e = 0; e < 4; ++e) { const float g = acc[ai][0][m][n][e] * r, uu = acc[ai][1][m][n][e] * r; o[n * 4 + e] = silu(g) * uu; }
                u32x4 w; w.x = pkbf(o[0], o[1]); w.y = pkbf(o[2], o[3]); w.z = pkbf(o[4], o[5]); w.w = pkbf(o[6], o[7]);
                *(u32x4*)(H + (size_t)row * DFF + col0) = w;
            }
    }
};
struct EpiRes {
    static constexpr bool PERM = true, AFTER_DRAIN = false;
    const float* base; float* out; bf16_t* hb; float* ssq_out; float alpha;
    __device__ __forceinline__ void operator()(const f32x4 (&acc)[2][2][4][2], const Unit& u, int wr, int wc, int fr, int fq) const {
        const int col0 = u.pn * 256 + wc * 32 + 8 * fq;
#pragma unroll
        for (int ai = 0; ai < 2; ++ai)
#pragma unroll
            for (int m = 0; m < 4; ++m) {
                const int row = u.pm * 256 + ai * 128 + wr * 64 + m * 16 + fr; float s = 0.f;
#pragma unroll
                for (int bj = 0; bj < 2; ++bj) {
                    const size_t off = (size_t)row * DM + col0 + bj * 128;
                    const f32x4 b0 = *(const f32x4*)(base + off), b1 = *(const f32x4*)(base + off + 4);
                    const f32x4 o0 = b0 + acc[ai][bj][m][0] * alpha, o1 = b1 + acc[ai][bj][m][1] * alpha;
                    *(f32x4*)(out + off) = o0; *(f32x4*)(out + off + 4) = o1;
                    u32x4 w; w.x = pkbf(o0[0], o0[1]); w.y = pkbf(o0[2], o0[3]); w.z = pkbf(o1[0], o1[1]); w.w = pkbf(o1[2], o1[3]);
                    *(u32x4*)(hb + off) = w;
                    s += (o0[0] * o0[0] + o0[1] * o0[1]) + (o0[2] * o0[2] + o0[3] * o0[3]) + (o1[0] * o1[0] + o1[1] * o1[1]) + (o1[2] * o1[2] + o1[3] * o1[3]);
                }
                s += __shfl_xor(s, 16); s += __shfl_xor(s, 32);
                if (fq == 0) unsafeAtomicAdd(ssq_out + row, s);
            }
    }
};
struct EpiBf16 {
    static constexpr bool PERM = true, AFTER_DRAIN = false;
    bf16_t* O; int ldc; const float* ssq; float scale;
    __device__ __forceinline__ void operator()(const f32x4 (&acc)[2][2][4][2], const Unit& u, int wr, int wc, int fr, int fq) const {
        const int col0 = u.pn * 256 + wc * 32 + 8 * fq;
#pragma unroll
        for (int ai = 0; ai < 2; ++ai)
#pragma unroll
            for (int m = 0; m < 4; ++m) {
                const int row = u.pm * 256 + ai * 128 + wr * 64 + m * 16 + fr; const float r = rstd_of(ssq, row) * scale;
#pragma unroll
                for (int bj = 0; bj < 2; ++bj) {
                    const f32x4 v0 = acc[ai][bj][m][0] * r, v1 = acc[ai][bj][m][1] * r;
                    u32x4 w; w.x = pkbf(v0[0], v0[1]); w.y = pkbf(v0[2], v0[3]); w.z = pkbf(v1[0], v1[1]); w.w = pkbf(v1[2], v1[3]);
                    *(u32x4*)(O + (size_t)row * ldc + col0 + bj * 128) = w;
                }
            }
    }
};
struct EpiHgrnIn {
    static constexpr bool PERM = true, AFTER_DRAIN = false;
    bf16_t* QH; unsigned short* LF; bf16_t* VH; bf16_t* GH; const float* ssq; const float* lb;
    __device__ __forceinline__ void operator()(const f32x4 (&acc)[2][2][4][2], const Unit& u, int wr, int wc, int fr, int fq) const {
        const int typ = u.pn >> 2; const int col0 = (u.pn & 3) * 256 + wc * 32 + 8 * fq;
        f32x4 lbv[2][2];
#pragma unroll
        for (int bj = 0; bj < 2; ++bj)
#pragma unroll
            for (int n = 0; n < 2; ++n) lbv[bj][n] = (typ == 1) ? *(const f32x4*)(lb + col0 + bj * 128 + 4 * n) : (f32x4){0.f, 0.f, 0.f, 0.f};
        bf16_t* dst = typ == 0 ? QH : (typ == 1 ? (bf16_t*)LF : (typ == 2 ? VH : GH));
#pragma unroll
        for (int ai = 0; ai < 2; ++ai)
#pragma unroll
            for (int m = 0; m < 4; ++m) {
                const int row = u.pm * 256 + ai * 128 + wr * 64 + m * 16 + fr; const float r = rstd_of(ssq, row);
#pragma unroll
                for (int bj = 0; bj < 2; ++bj) {
                    const f32x4 v0 = acc[ai][bj][m][0] * r, v1 = acc[ai][bj][m][1] * r;
                    u32x4 w;
                    if (typ == 1) {
                        unsigned q[8];
#pragma unroll
                        for (int e = 0; e < 8; ++e) { const float x = e < 4 ? v0[e & 3] : v1[e & 3]; const float l = e < 4 ? lbv[bj][0][e & 3] : lbv[bj][1][e & 3];
                            const float f = l + (1.f - l) * sigm(x); const float nl = -__logf(f) * 32768.f; q[e] = (unsigned)fminf(fmaxf(rintf(nl), 0.f), 65535.f); }
                        w.x = q[0] | (q[1] << 16); w.y = q[2] | (q[3] << 16); w.z = q[4] | (q[5] << 16); w.w = q[6] | (q[7] << 16);
                    } else if (typ == 2) {
                        w.x = pkbf(v0[0], v0[1]); w.y = pkbf(v0[2], v0[3]); w.z = pkbf(v1[0], v1[1]); w.w = pkbf(v1[2], v1[3]);
                    } else {
                        w.x = pkbf(silu(v0[0]), silu(v0[1])); w.y = pkbf(silu(v0[2]), silu(v0[3])); w.z = pkbf(silu(v1[0]), silu(v1[1])); w.w = pkbf(silu(v1[2]), silu(v1[3]));
                    }
                    *(u32x4*)(dst + (size_t)row * DM + col0 + bj * 128) = w;
                }
            }
    }
};
}

__device__ __forceinline__ int swmap(int n) { return n < DFF ? ((n >> 7) * 256 + (n & 127)) : (((n - DFF) >> 7) * 256 + 128 + ((n - DFF) & 127)); }
__device__ __forceinline__ void transpose_item(const float* W, int K, int N, bf16_t* WT, const float* nw, int mode, LAS float* scr, int item, int lane) {
    const int nblk = N / 32, kb = item / nblk, nb = item % nblk, k0 = 64 * kb, n0 = 32 * nb;
#pragma unroll 8
    for (int i = 0; i < 32; ++i) { const int kk = 2 * i + (lane >> 5); float v = W[(size_t)(k0 + kk) * N + n0 + (lane & 31)]; if (nw) v *= nw[k0 + kk]; scr[kk * 33 + (lane & 31)] = v; }
    asm volatile("s_waitcnt lgkmcnt(0)" ::: "memory");
    const int c = lane & 7; const int r0 = mode ? swmap(n0) : n0;
#pragma unroll
    for (int j = 0; j < 4; ++j) { const int n = (lane >> 3) + 8 * j; const LAS float* s = scr + (8 * c) * 33 + n;
        u32x4 o; o.x = pkbf(s[0 * 33], s[1 * 33]); o.y = pkbf(s[2 * 33], s[3 * 33]); o.z = pkbf(s[4 * 33], s[5 * 33]); o.w = pkbf(s[6 * 33], s[7 * 33]);
        *(u32x4*)(WT + (size_t)(r0 + n) * K + k0 + 8 * c) = o; }
    asm volatile("s_waitcnt lgkmcnt(0)" ::: "memory");
}
__device__ __forceinline__ void convert_weight(const float* W, int K, int N, bf16_t* WT, const float* nw, int mode, LAS float* scr, int gw, int ngw, int lane) {
    const int nitems = (K / 64) * (N / 32);
    for (int it = gw; it < nitems; it += ngw) transpose_item(W, K, N, WT, nw, mode, scr, it, lane);
}

namespace hg {
constexpr int C = 64, NCH = SEQ / C, NUNIT = BATCH * 8 * NCH;
constexpr int RS = 272, RT = 144;
constexpr int L_QD = 0, L_QI = 64 * RS, L_KI = 2 * 64 * RS, L_SP = 3 * 64 * RS, L_VT = L_SP + 128 * RS, L_AM = L_VT + 128 * RT, L_PART = L_AM + 64 * RT, L_END = L_PART + 2048;
constexpr int L1_KDT = 0, L1_VT = 128 * RT, L1_PART = 2 * 128 * RT;
static_assert(L_END <= 131072, "hgrn lds");

__device__ __forceinline__ void load_bcum(const unsigned short* LF, size_t row0, int h, int dk, int cq, LAS float* part, float (&lf)[16], float (&bc)[16], float& bmid, float& blast) {
    const unsigned short* p = LF + (row0 + 16 * cq) * DM + h * 128 + dk;
#pragma unroll
    for (int i = 0; i < 16; ++i) lf[i] = -(float)p[(size_t)i * DM] * (1.f / 32768.f);
    float run = 0.f;
#pragma unroll
    for (int i = 0; i < 16; ++i) { run += lf[i]; bc[i] = run; }
    part[cq * 128 + dk] = run;
    __syncthreads();
    const float p0 = part[dk], p1 = part[128 + dk], p2 = part[256 + dk], p3 = part[384 + dk];
    const float off = cq == 0 ? 0.f : (cq == 1 ? p0 : (cq == 2 ? p0 + p1 : p0 + p1 + p2));
    bmid = p0 + p1; blast = (p0 + p1) + (p2 + p3);
#pragma unroll
    for (int i = 0; i < 16; ++i) bc[i] += off;
}
__device__ __forceinline__ void stage_vt(const bf16_t* VH, size_t row0, int h, int dv, int cq, LAS unsigned char* vt) {
    const bf16_t* p = VH + (row0 + 16 * cq) * DM + h * 128 + dv;
    unsigned short v[16];
#pragma unroll
    for (int i = 0; i < 16; ++i) v[i] = p[(size_t)i * DM];
    u32x4 a, b;
    a.x = v[0] | ((unsigned)v[1] << 16); a.y = v[2] | ((unsigned)v[3] << 16); a.z = v[4] | ((unsigned)v[5] << 16); a.w = v[6] | ((unsigned)v[7] << 16);
    b.x = v[8] | ((unsigned)v[9] << 16); b.y = v[10] | ((unsigned)v[11] << 16); b.z = v[12] | ((unsigned)v[13] << 16); b.w = v[14] | ((unsigned)v[15] << 16);
    *(LAS u32x4*)(vt + dv * RT + cq * 32) = a; *(LAS u32x4*)(vt + dv * RT + cq * 32 + 16) = b;
}
__device__ __forceinline__ void h1_phase(LAS unsigned char* L, const unsigned short* LF, const bf16_t* VH, bf16_t* UT, float* DEC, int wave_s) {
    const int tid = fresh_tid(wave_s), lane = tid & 63, w = wave_s, dk = tid & 127, cq = tid >> 7, r32 = lane & 31, hi = lane >> 5;
    for (int unit = blockIdx.x; unit < NUNIT; unit += gridDim.x) {
        const int b = unit >> 10, h = (unit >> 7) & 7, n = unit & 127; const size_t row0 = (size_t)b * SEQ + (size_t)n * C;
        float lf[16], bc[16], bmid, blast;
        load_bcum(LF, row0, h, dk, cq, (LAS float*)(L + L1_PART), lf, bc, bmid, blast);
        unsigned pk[8];
#pragma unroll
        for (int i = 0; i < 16; i += 2) { const float k0 = (1.f - fexp(lf[i])) * fexp(blast - bc[i]), k1 = (1.f - fexp(lf[i + 1])) * fexp(blast - bc[i + 1]); pk[i >> 1] = pkbf(k0, k1); }
        *(LAS u32x4*)(L + L1_KDT + dk * RT + cq * 32) = (u32x4){pk[0], pk[1], pk[2], pk[3]};
        *(LAS u32x4*)(L + L1_KDT + dk * RT + cq * 32 + 16) = (u32x4){pk[4], pk[5], pk[6], pk[7]};
        stage_vt(VH, row0, h, dk, cq, L + L1_VT);
        if (cq == 3) DEC[(size_t)unit * 128 + dk] = fexp(blast);
        __syncthreads();
        const int dvb = (w & 3) * 32, dkb = (w >> 2) * 64;
        f32x16 acc[2]; acc[0] = f32x16{}; acc[1] = f32x16{};
#pragma unroll
        for (int kk = 0; kk < 4; ++kk) {
            const bf16x8 a = *(const LAS bf16x8*)(L + L1_VT + (dvb + r32) * RT + (kk * 16 + 8 * hi) * 2);
#pragma unroll
            for (int t = 0; t < 2; ++t) { const bf16x8 bb = *(const LAS bf16x8*)(L + L1_KDT + (dkb + 32 * t + r32) * RT + (kk * 16 + 8 * hi) * 2);
                acc[t] = __builtin_amdgcn_mfma_f32_32x32x16_bf16(a, bb, acc[t], 0, 0, 0); }
        }
        bf16_t* up = UT + (size_t)unit * 16384;
#pragma unroll
        for (int t = 0; t < 2; ++t)
#pragma unroll
            for (int r = 0; r < 16; ++r) up[(dvb + crow(r, hi)) * 128 + dkb + 32 * t + r32] = f2bf(acc[t][r]);
        __syncthreads();
    }
}
__device__ __forceinline__ void scan_phase(bf16_t* UT, const float* DEC, int wave_s) {
    const int gt = blockIdx.x * NTHR + fresh_tid(wave_s), ngt = gridDim.x * NTHR;
    for (int g = gt; g < 32 * 4096; g += ngt) {
        const int bh = g >> 12, e = (g & 4095) * 4, dk = e & 127;
        float s0 = 0.f, s1 = 0.f, s2 = 0.f, s3 = 0.f;
        bf16_t* up = UT + (size_t)bh * 128 * 16384 + e; const float* dp = DEC + (size_t)bh * 128 * 128 + dk;
        for (int n0 = 0; n0 < NCH; n0 += 8) {
            u32x2 uu[8]; f32x4 dd[8];
#pragma unroll
            for (int j = 0; j < 8; ++j) { uu[j] = *(const u32x2*)(up + (size_t)(n0 + j) * 16384); dd[j] = *(const f32x4*)(dp + (size_t)(n0 + j) * 128); }
#pragma unroll
            for (int j = 0; j < 8; ++j) {
                u32x2 o; o.x = pkbf(s0, s1); o.y = pkbf(s2, s3);
                *(u32x2*)(up + (size_t)(n0 + j) * 16384) = o;
                s0 = dd[j][0] * s0 + __uint_as_float(uu[j].x << 16); s1 = dd[j][1] * s1 + __uint_as_float(uu[j].x & 0xffff0000u);
                s2 = dd[j][2] * s2 + __uint_as_float(uu[j].y << 16); s3 = dd[j][3] * s3 + __uint_as_float(uu[j].y & 0xffff0000u);
            }
        }
    }
}
__device__ __forceinline__ void h3_phase(LAS unsigned char* L, bf16_t* QH, const unsigned short* LF, const bf16_t* VH, const bf16_t* GH, const bf16_t* SP, const float* gnw, int wave_s) {
    const int tid = fresh_tid(wave_s), lane = tid & 63, w = wave_s, dk = tid & 127, cq = tid >> 7, r32 = lane & 31, hi = lane >> 5;
    for (int unit = blockIdx.x; unit < NUNIT; unit += gridDim.x) {
        const int b = unit >> 10, h = (unit >> 7) & 7, n = unit & 127; const size_t row0 = (size_t)b * SEQ + (size_t)n * C;
        {
            const bf16_t* sp = SP + (size_t)unit * 16384;
#pragma unroll
            for (int j = 0; j < 4; ++j) { const int idx = tid + 512 * j, row = idx >> 4, pc = idx & 15; *(LAS u32x4*)(L + L_SP + row * RS + pc * 16) = *(const u32x4*)(sp + row * 128 + pc * 8); }
        }
        stage_vt(VH, row0, h, dk, cq, L + L_VT);
        {
            float lf[16], bc[16], bmid, blast;
            load_bcum(LF, row0, h, dk, cq, (LAS float*)(L + L_PART), lf, bc, bmid, blast);
            const bf16_t* qp = QH + (row0 + 16 * cq) * DM + h * 128 + dk;
#pragma unroll
            for (int i = 0; i < 16; ++i) {
                const float q = bf2f(qp[(size_t)i * DM]); const float k = 1.f - fexp(lf[i]);
                const int c = 16 * cq + i;
                *(LAS unsigned short*)(L + L_QD + c * RS + dk * 2) = f2bf(q * fexp(bc[i]));
                *(LAS unsigned short*)(L + L_QI + c * RS + dk * 2) = f2bf(q * fexp(bc[i] - bmid));
                *(LAS unsigned short*)(L + L_KI + c * RS + dk * 2) = f2bf(k * fexp(bmid - bc[i]));
            }
        }
        __syncthreads();
        if (w < 4) {
            const int cb = (w & 1) * 32, cpb = (w >> 1) * 32;
            f32x16 a = f32x16{};
            if (!(cb == 0 && cpb == 32)) {
#pragma unroll
                for (int kk = 0; kk < 8; ++kk) {
                    const bf16x8 fa = *(const LAS bf16x8*)(L + L_QI + (cb + r32) * RS + (kk * 16 + 8 * hi) * 2);
                    const bf16x8 fb = *(const LAS bf16x8*)(L + L_KI + (cpb + r32) * RS + (kk * 16 + 8 * hi) * 2);
                    a = __builtin_amdgcn_mfma_f32_32x32x16_bf16(fa, fb, a, 0, 0, 0);
                }
            }
#pragma unroll
            for (int r = 0; r < 16; ++r) { const int c = cb + crow(r, hi), cp = cpb + r32; *(LAS unsigned short*)(L + L_AM + c * RT + cp * 2) = f2bf(cp <= c ? a[r] : 0.f); }
        }
        const int cb = (w & 1) * 32, dvb = (w >> 1) * 32;
        f32x16 o = f32x16{};
#pragma unroll
        for (int kk = 0; kk < 8; ++kk) {
            const bf16x8 fa = *(const LAS bf16x8*)(L + L_QD + (cb + r32) * RS + (kk * 16 + 8 * hi) * 2);
            const bf16x8 fb = *(const LAS bf16x8*)(L + L_SP + (dvb + r32) * RS + (kk * 16 + 8 * hi) * 2);
            o = __builtin_amdgcn_mfma_f32_32x32x16_bf16(fa, fb, o, 0, 0, 0);
        }
        __syncthreads();
#pragma unroll
        for (int kk = 0; kk < 4; ++kk) {
            const bf16x8 fa = *(const LAS bf16x8*)(L + L_AM + (cb + r32) * RT + (kk * 16 + 8 * hi) * 2);
            const bf16x8 fb = *(const LAS bf16x8*)(L + L_VT + (dvb + r32) * RT + (kk * 16 + 8 * hi) * 2);
            o = __builtin_amdgcn_mfma_f32_32x32x16_bf16(fa, fb, o, 0, 0, 0);
        }
        __syncthreads();
        LAS float* OF = (LAS float*)(L + L_QD);
#pragma unroll
        for (int r = 0; r < 16; ++r) OF[(cb + crow(r, hi)) * 132 + dvb + r32] = o[r];
        __syncthreads();
        {
            const int c = tid >> 3, seg = tid & 7;
            f32x4 v[4]; float ss = 0.f;
#pragma unroll
            for (int j = 0; j < 4; ++j) { v[j] = *(const LAS f32x4*)(OF + c * 132 + seg * 16 + 4 * j); ss += (v[j][0] * v[j][0] + v[j][1] * v[j][1]) + (v[j][2] * v[j][2] + v[j][3] * v[j][3]); }
            ss += __shfl_xor(ss, 1); ss += __shfl_xor(ss, 2); ss += __shfl_xor(ss, 4);
            const float rs = rsqrtf(ss * (1.f / 128.f) + EPS);
            const size_t off = (row0 + c) * DM + h * 128 + seg * 16;
            const u32x4 g0 = *(const u32x4*)(GH + off), g1 = *(const u32x4*)(GH + off + 8);
            const unsigned gg[8] = {g0.x, g0.y, g0.z, g0.w, g1.x, g1.y, g1.z, g1.w};
            unsigned ow[8];
#pragma unroll
            for (int j = 0; j < 4; ++j) {
                const f32x4 wv = *(const f32x4*)(gnw + seg * 16 + 4 * j);
                const float a0 = v[j][0] * rs * wv[0] * __uint_as_float(gg[2 * j] << 16), a1 = v[j][1] * rs * wv[1] * __uint_as_float(gg[2 * j] & 0xffff0000u);
                const float a2 = v[j][2] * rs * wv[2] * __uint_as_float(gg[2 * j + 1] << 16), a3 = v[j][3] * rs * wv[3] * __uint_as_float(gg[2 * j + 1] & 0xffff0000u);
                ow[2 * j] = pkbf(a0, a1); ow[2 * j + 1] = pkbf(a2, a3);
            }
            *(u32x4*)(QH + off) = (u32x4){ow[0], ow[1], ow[2], ow[3]}; *(u32x4*)(QH + off + 8) = (u32x4){ow[4], ow[5], ow[6], ow[7]};
        }
        __syncthreads();
    }
}
}

__device__ __forceinline__ void x_prologue(const float* x, bf16_t* hb, float* ssq0, int gw, int ngw, int lane) {
    for (int m = gw; m < MTOK; m += ngw) {
        const f32x4* xr = (const f32x4*)(x + (size_t)m * DM) + lane; f32x4 v[4]; float s = 0.f;
#pragma unroll
        for (int j = 0; j < 4; ++j) { v[j] = xr[64 * j]; s += (v[j][0] * v[j][0] + v[j][1] * v[j][1]) + (v[j][2] * v[j][2] + v[j][3] * v[j][3]); }
        s = wave_sum(s);
        u32x2* o = (u32x2*)(hb + (size_t)m * DM) + lane;
#pragma unroll
        for (int j = 0; j < 4; ++j) { u32x2 w; w.x = pkbf(v[j][0], v[j][1]); w.y = pkbf(v[j][2], v[j][3]); o[64 * j] = w; }
        if (lane == 0) ssq0[m] = s;
    }
}
__device__ __forceinline__ void combine_phase(const bf16_t* OB, bf16_t* AO, const float* subw, const float* lamp, int wave_s) {
    const float lam = *lamp;
    const int gt = blockIdx.x * NTHR + fresh_tid(wave_s), ngt = gridDim.x * NTHR;
    const int sub = gt & 15;
    f32x4 w0 = *(const f32x4*)(subw + sub * 8), w1 = *(const f32x4*)(subw + sub * 8 + 4);
    for (int g = gt >> 4; g < MTOK * 8; g += ngt >> 4) {
        const int row = g >> 3, h = g & 7;
        const u32x4 a = *(const u32x4*)(OB + (size_t)row * 2048 + h * 128 + sub * 8), bq = *(const u32x4*)(OB + (size_t)row * 2048 + 1024 + h * 128 + sub * 8);
        const unsigned aa[4] = {a.x, a.y, a.z, a.w}, bb[4] = {bq.x, bq.y, bq.z, bq.w};
        float o[8]; float ss = 0.f;
#pragma unroll
        for (int j = 0; j < 4; ++j) { o[2 * j] = __uint_as_float(aa[j] << 16) - lam * __uint_as_float(bb[j] << 16); o[2 * j + 1] = __uint_as_float(aa[j] & 0xffff0000u) - lam * __uint_as_float(bb[j] & 0xffff0000u);
            ss += o[2 * j] * o[2 * j] + o[2 * j + 1] * o[2 * j + 1]; }
        ss += __shfl_xor(ss, 1); ss += __shfl_xor(ss, 2); ss += __shfl_xor(ss, 4); ss += __shfl_xor(ss, 8);
        const float rs = rsqrtf(ss * (1.f / 128.f) + EPS) * (1.f - LAMBDA_INIT);
        u32x4 wv; wv.x = pkbf(o[0] * rs * w0[0], o[1] * rs * w0[1]); wv.y = pkbf(o[2] * rs * w0[2], o[3] * rs * w0[3]); wv.z = pkbf(o[4] * rs * w1[0], o[5] * rs * w1[1]); wv.w = pkbf(o[6] * rs * w1[2], o[7] * rs * w1[3]);
        *(u32x4*)(AO + (size_t)row * DM + h * 128 + sub * 8) = wv;
    }
}
__device__ __forceinline__ void final_norm(float* out, const float* fw, int gw, int ngw, int lane) {
    f32x4 wv[4];
#pragma unroll
    for (int j = 0; j < 4; ++j) wv[j] = *((const f32x4*)fw + lane + 64 * j);
    for (int m = gw; m < MTOK; m += ngw) {
        f32x4* xr = (f32x4*)(out + (size_t)m * DM) + lane; f32x4 v[4]; float s = 0.f;
#pragma unroll
        for (int j = 0; j < 4; ++j) { v[j] = xr[64 * j]; s += (v[j][0] * v[j][0] + v[j][1] * v[j][1]) + (v[j][2] * v[j][2] + v[j][3] * v[j][3]); }
        const float rs = rsqrtf(wave_sum(s) * (1.f / 1024.f) + EPS);
#pragma unroll
        for (int j = 0; j < 4; ++j) xr[64 * j] = v[j] * rs * wv[j];
    }
}
__device__ __forceinline__ int t5_bucket(int n) {
    if (n < 16) return n;
    const float nf = (float)n; int large = 16 + (int)(logf(nf / 16.f) / 2.0794415416798357f * 16.f);
    return large < 31 ? large : 31;
}

struct Args { const float* in[16]; float* out; unsigned char* ws; int ph_lo, ph_hi, coop, pad; };
constexpr int N_PHASES = 19;

__global__ void __launch_bounds__(NTHR, 2) yoco_fwd(Args args) {
    extern __shared__ __attribute__((aligned(16))) unsigned char lds[];
    LAS unsigned char* L = (LAS unsigned char*)lds;
    const int wave = __builtin_amdgcn_readfirstlane(threadIdx.x >> 6);
    const int G = gridDim.x, gw = blockIdx.x * NWAVES + wave, ngw = G * NWAVES;
    unsigned char* ws = args.ws;
    const float* x = args.in[0]; const float* norm_w = args.in[1]; const float* ffn_w_in = args.in[2]; const float* ffn_w_out = args.in[3];
    float* ssq = (float*)(ws + WS_SSQ); float* lbv = (float*)(ws + WS_LB); float* btab = (float*)(ws + WS_BTAB); float* lamp = (float*)(ws + WS_LAM);
    bf16_t* HB = (bf16_t*)(ws + WS_HB); bf16_t* HID = (bf16_t*)(ws + WS_HID); float* OUT = args.out;
    const int lo = args.ph_lo, hi = args.ph_hi;
    cg::grid_group grid = cg::this_grid();
#define IN(k) (lo <= (k) && (k) < hi)
#define SEAM(k) do { if (args.coop && IN(k) && IN((k) + 1)) grid.sync(); } while (0)
#define GEMM_PHASE(EPI, Aptr, Bptr, NN, KK, ...) do { pg8::Gemm g_{(const bf16_t*)(Aptr), (const bf16_t*)(Bptr), MTOK, (NN), (KK)}; pg8::StaticOrder S_; S_.init(MTOK, (NN), G, (int)blockIdx.x); \
        EPI E_{__VA_ARGS__}; pg8::gemm_phase<EPI, pg8::StaticOrder, true, true>(L, g_, S_, E_, wave); } while (0)
    LAS float* scr = (LAS float*)(L + wave * 16384);

    if (IN(0)) {
        const int tid = fresh_tid(wave), lane = tid & 63;
        convert_weight(ffn_w_in, 1024, NFF, (bf16_t*)(ws + WS_FI00), norm_w + 0 * 1024, 1, scr, gw, ngw, lane);
        convert_weight(ffn_w_in + (size_t)1 * 1024 * NFF, 1024, NFF, (bf16_t*)(ws + WS_FI01), norm_w + 2 * 1024, 1, scr, gw, ngw, lane);
        convert_weight(ffn_w_out, DFF, 1024, (bf16_t*)(ws + WS_FO00), nullptr, 0, scr, gw, ngw, lane);
        convert_weight(ffn_w_out + (size_t)1 * DFF * 1024, DFF, 1024, (bf16_t*)(ws + WS_FO01), nullptr, 0, scr, gw, ngw, lane);
        convert_weight(args.in[4], 1024, 4096, (bf16_t*)(ws + WS_HIN), norm_w + 1 * 1024, 0, scr, gw, ngw, lane);
        convert_weight(args.in[7], 1024, 1024, (bf16_t*)(ws + WS_HOUT), nullptr, 0, scr, gw, ngw, lane);
        x_prologue(x, HB, ssq, gw, ngw, lane);
        for (int i = blockIdx.x * NTHR + tid; i < 6 * MTOK; i += G * NTHR) ssq[MTOK + i] = 0.f;
        if (blockIdx.x == 0) {
            const float* hlb = args.in[5];
            for (int i = tid; i < 1024; i += NTHR) { const float a0 = hlb[i], a1 = hlb[1024 + i]; lbv[i] = 1.f / (1.f + expf(a1 - a0)); }
            const float* rb = args.in[10];
            for (int i = tid; i < 1024; i += NTHR) { const int h = i >> 7, d = i & 127; btab[i] = (rb[t5_bucket(d) * 8 + h] - rb[31 * 8 + h]) * LOG2E; }
            if (wave == 0) { const float* lp = args.in[12]; const float a = wave_sum(lp[lane] * lp[64 + lane]), b2 = wave_sum(lp[128 + lane] * lp[192 + lane]);
                if (lane == 0) *lamp = expf(a) - expf(b2) + LAMBDA_INIT; }
        }
    }
    SEAM(0);
    if (IN(1)) GEMM_PHASE(epi::EpiSwiglu, HB, ws + WS_FI00, NFF, 1024, HID, ssq + 0 * MTOK);
    SEAM(1);
    if (IN(2)) GEMM_PHASE(epi::EpiRes, HID, ws + WS_FO00, 1024, DFF, x, OUT, HB, ssq + 1 * MTOK, 0.5f);
    SEAM(2);
    if (IN(3)) GEMM_PHASE(epi::EpiHgrnIn, HB, ws + WS_HIN, 4096, 1024, (bf16_t*)(ws + WS_QH), (unsigned short*)(ws + WS_LF), (bf16_t*)(ws + WS_VH), (bf16_t*)(ws + WS_GH), ssq + 1 * MTOK, lbv);
    SEAM(3);
    if (IN(4)) hg::h1_phase(L, (const unsigned short*)(ws + WS_LF), (const bf16_t*)(ws + WS_VH), (bf16_t*)(ws + WS_UT), (float*)(ws + WS_DEC), wave);
    SEAM(4);
    if (IN(5)) hg::scan_phase((bf16_t*)(ws + WS_UT), (const float*)(ws + WS_DEC), wave);
    SEAM(5);
    if (IN(6)) hg::h3_phase(L, (bf16_t*)(ws + WS_QH), (const unsigned short*)(ws + WS_LF), (const bf16_t*)(ws + WS_VH), (const bf16_t*)(ws + WS_GH), (const bf16_t*)(ws + WS_UT), args.in[6], wave);
    SEAM(6);
    if (IN(7)) GEMM_PHASE(epi::EpiRes, ws + WS_QH, ws + WS_HOUT, 1024, 1024, OUT, OUT, HB, ssq + 2 * MTOK, 1.0f);
    SEAM(7);
    if (IN(8)) {
        const int lane = fresh_tid(wave) & 63;
        convert_weight(ffn_w_in + (size_t)2 * 1024 * NFF, 1024, NFF, (bf16_t*)(ws + WS_FI10), norm_w + 3 * 1024, 1, scr, gw, ngw, lane);
        convert_weight(ffn_w_in + (size_t)3 * 1024 * NFF, 1024, NFF, (bf16_t*)(ws + WS_FI11), norm_w + 5 * 1024, 1, scr, gw, ngw, lane);
        convert_weight(ffn_w_out + (size_t)2 * DFF * 1024, DFF, 1024, (bf16_t*)(ws + WS_FO10), nullptr, 0, scr, gw, ngw, lane);
        convert_weight(ffn_w_out + (size_t)3 * DFF * 1024, DFF, 1024, (bf16_t*)(ws + WS_FO11), nullptr, 0, scr, gw, ngw, lane);
        convert_weight(args.in[9], 1024, 2048, (bf16_t*)(ws + WS_WKV), args.in[8], 0, scr, gw, ngw, lane);
        convert_weight(args.in[11], 1024, 1024, (bf16_t*)(ws + WS_WQ), norm_w + 4 * 1024, 0, scr, gw, ngw, lane);
        convert_weight(args.in[14], 1024, 1024, (bf16_t*)(ws + WS_WAO), nullptr, 0, scr, gw, ngw, lane);
        __syncthreads();
        GEMM_PHASE(epi::EpiSwiglu, HB, ws + WS_FI01, NFF, 1024, HID, ssq + 2 * MTOK);
    }
    SEAM(8);
    if (IN(9)) GEMM_PHASE(epi::EpiRes, HID, ws + WS_FO01, 1024, DFF, OUT, OUT, HB, ssq + 3 * MTOK, 0.5f);
    SEAM(9);
    if (IN(10)) {
        GEMM_PHASE(epi::EpiBf16, HB, ws + WS_WKV, 2048, 1024, (bf16_t*)(ws + WS_KV), 2048, ssq + 3 * MTOK, 1.0f);
        GEMM_PHASE(epi::EpiSwiglu, HB, ws + WS_FI10, NFF, 1024, HID, ssq + 3 * MTOK);
    }
    SEAM(10);
    if (IN(11)) GEMM_PHASE(epi::EpiRes, HID, ws + WS_FO10, 1024, DFF, OUT, OUT, HB, ssq + 4 * MTOK, 0.5f);
    SEAM(11);
    if (IN(12)) GEMM_PHASE(epi::EpiBf16, HB, ws + WS_WQ, 1024, 1024, (bf16_t*)(ws + WS_QB), 1024, ssq + 4 * MTOK, QSCALE);
    SEAM(12);
    if (IN(13)) {
        const attn_body::AttnTensors AT{(const attn_body::bf16*)(ws + WS_QB), (const attn_body::bf16*)(ws + WS_KV), (const attn_body::bf16*)(ws + WS_KV), (attn_body::bf16*)(ws + WS_OB), btab};
        const attn_body::StaticOrder S((int)G, (int)blockIdx.x);
        attn_body::attn_phase<attn_body::StaticOrder>((char*)lds, AT, S, wave);
    }
    SEAM(13);
    if (IN(14)) combine_phase((const bf16_t*)(ws + WS_OB), (bf16_t*)(ws + WS_QB), args.in[13], lamp, wave);
    SEAM(14);
    if (IN(15)) GEMM_PHASE(epi::EpiRes, ws + WS_QB, ws + WS_WAO, 1024, 1024, OUT, OUT, HB, ssq + 5 * MTOK, 1.0f);
    SEAM(15);
    if (IN(16)) GEMM_PHASE(epi::EpiSwiglu, HB, ws + WS_FI11, NFF, 1024, HID, ssq + 5 * MTOK);
    SEAM(16);
    if (IN(17)) GEMM_PHASE(epi::EpiRes, HID, ws + WS_FO11, 1024, DFF, OUT, OUT, HB, ssq + 6 * MTOK, 0.5f);
    SEAM(17);
    if (IN(18)) final_norm(OUT, args.in[15], gw, ngw, fresh_tid(wave) & 63);
#undef IN
#undef SEAM
#undef GEMM_PHASE
}

#ifndef MK_COOP
#define MK_COOP 1
#endif
extern "C" void kernel_launch(void* const* d_in, const int* in_sizes, int n_in, void* d_out, int out_size, void* d_ws, size_t ws_size, hipStream_t stream) {
    static int grid = 0;
    if (grid == 0) {
        if (n_in != 16 || in_sizes[0] != MTOK * DM || out_size != MTOK * DM || ws_size < WS_END) { fprintf(stderr, "kernel_launch: unexpected shapes (n_in %d, in0 %d, out %d, ws %zu)\n", n_in, n_in > 0 ? in_sizes[0] : -1, out_size, ws_size); grid = -1; return; }
        int dev = 0, cus = 0, per_cu = 0;
        hipGetDevice(&dev); hipDeviceGetAttribute(&cus, hipDeviceAttributeMultiprocessorCount, dev);
        hipFuncSetAttribute((const void*)yoco_fwd, hipFuncAttributeMaxDynamicSharedMemorySize, LDS_BYTES);
        hipOccupancyMaxActiveBlocksPerMultiprocessor(&per_cu, (const void*)yoco_fwd, NTHR, LDS_BYTES);
        if (per_cu < 1) { fprintf(stderr, "kernel_launch: occupancy query says %d blocks per CU\n", per_cu); per_cu = 1; }
        (void)hipGetLastError();
        grid = cus;
        if (grid > 256) grid = 256;
        grid &= ~7;
    }
    if (grid <= 0) return;
    Args a{};
    for (int i = 0; i < 16; ++i) a.in[i] = (const float*)d_in[i];
    a.out = (float*)d_out; a.ws = (unsigned char*)d_ws;
#if MK_COOP
    a.ph_lo = 0; a.ph_hi = N_PHASES; a.coop = 1;
    void* kargs[] = {&a};
    hipError_t e = hipLaunchCooperativeKernel((const void*)yoco_fwd, dim3(grid), dim3(NTHR), kargs, LDS_BYTES, stream);
    if (e != hipSuccess) fprintf(stderr, "cooperative launch failed: %s (grid %d)\n", hipGetErrorString(e), grid);
#else
    for (int p = 0; p < N_PHASES; ++p) { a.ph_lo = p; a.ph_hi = p + 1; a.coop = 0; hipLaunchKernelGGL(yoco_fwd, dim3(grid), dim3(NTHR), LDS_BYTES, stream, a); }
#endif
}
```

```cpp
#include <hip/hip_runtime.h>
#include <hip/hip_bf16.h>
#include <hip/hip_cooperative_groups.h>
#include <cstdio>
#include <cstdint>
#include <cmath>
namespace cg = cooperative_groups;
__device__ __forceinline__ int fresh_tid(int wave_s) { int l; asm volatile("v_mbcnt_lo_u32_b32 %0, -1, 0\n\tv_mbcnt_hi_u32_b32 %0, -1, %0" : "=v"(l)); return wave_s * 64 + l; }
namespace pg8 {
#define PG8_LAS __attribute__((address_space(3)))
typedef unsigned short bf16_t;
typedef short bf16x8 __attribute__((ext_vector_type(8)));
typedef float f32x4 __attribute__((ext_vector_type(4)));
typedef unsigned u32x4 __attribute__((ext_vector_type(4)));
constexpr int BM = 256, BK = 64, HALF = 128, HTB = HALF * BK * 2  , STAGE_BYTES = 8 * HTB, NXCD = 8, WGM = 8;

__host__ __device__ __forceinline__ int lds_byte(int r, int c) { const int st = (r >> 4) * 2 + (c >> 5), rr = r & 15, cc = c & 31, ob = rr * 64 + cc * 2; return st * 1024 + (ob ^ (((ob >> 9) & 1) << 5)); }
__host__ __device__ __forceinline__ void stage_rc(int b, int& R, int& C) { const int st = b / 1024, sb = b % 1024, swz = sb ^ (((sb >> 9) & 1) << 5); R = (st >> 1) * 16 + swz / 64; C = (st & 1) * 32 + (swz % 64) / 2; }
__host__ __device__ __forceinline__ int perm32(int rho) { const int n = rho >> 4, i = rho & 15; return 8 * (i >> 2) + 4 * n + (i & 3); }

struct Unit { int pm, pn; };
struct Gemm { const bf16_t* A; const bf16_t* Bt; int M, N, K; };

struct StaticOrder {
    int nM, nN, nwg, G, c;
    __host__ __device__ void init(int M, int N, int G_, int c_) { nM = M / BM; nN = N / BM; nwg = nM * nN; G = G_; c = c_; }
    __host__ __device__ bool next(int i, Unit& u) const {
        const long L = (long)i * G + c; if (L >= nwg) return false;
        int wgid = (int)L; { const int q = nwg / NXCD, r = nwg % NXCD, xcd = wgid % NXCD, off = wgid / NXCD; wgid = (xcd < r ? xcd * (q + 1) : r * (q + 1) + (xcd - r) * q) + off; }
        const int nig = WGM * nN, gid = wgid / nig, fm = gid * WGM, gsz = (nM - fm) < WGM ? (nM - fm) : WGM;
        u.pm = fm + ((wgid % nig) % gsz); u.pn = (wgid % nig) / gsz; return true;
    }
    __device__ __forceinline__ void a_ready(const Unit&) const {}
    __device__ __forceinline__ void done(const Unit&) const {}
};

__device__ __forceinline__ unsigned cvt_pk_bf16(float lo, float hi) { unsigned r; asm volatile("v_cvt_pk_bf16_f32 %0, %1, %2" : "=v"(r) : "v"(lo), "v"(hi)); return r; }
typedef float f32x2 __attribute__((ext_vector_type(2)));
template <class Epi, class Sched, bool ALIGN_EPI = false, bool SP2 = false>
__device__ __forceinline__ void gemm_phase(PG8_LAS unsigned char* lds, const Gemm g, const Sched& S, const Epi& E, int wave_s) {
    const int tid = fresh_tid(wave_s), wid = wave_s, lane = tid & 63, wr = wid >> 2, wc = wid & 3, fr = lane & 15, fq = lane >> 4;
    const int K = g.K, nt = K / BK;
    unsigned voffA[2], voffB[2];
#pragma unroll
    for (int i = 0; i < 2; ++i) { int R, C; stage_rc(tid * 16 + i * 8192, R, C); const int Rb = Epi::PERM ? ((R & ~31) + perm32(R & 31)) : R;
        voffA[i] = (unsigned)(R * K + C) * 2u; voffB[i] = (unsigned)(Rb * K + C) * 2u; }
    const size_t kstep = (size_t)(BK * 2);
    const size_t hstep = (size_t)HALF * K * 2;
    const size_t tstep = 2 * hstep;
    const unsigned ldsw = (unsigned)wid * 1024u;
    const int aoff = lds_byte(wr * 64 + fr, fq * 8), boff = lds_byte(wc * 32 + fr, fq * 8);
#define PG8_SA(b, h) (((b) * 2 + (h)) * HTB)
#define PG8_SB(b, h) ((4 + (b) * 2 + (h)) * HTB)
#define PG8_STAGE(bufoff, gbase, voff) do { _Pragma("unroll") for (int _i = 0; _i < 2; ++_i) \
        __builtin_amdgcn_global_load_lds((const unsigned*)((const char*)(gbase) + (voff)[_i]), (PG8_LAS unsigned*)(lds + (bufoff) + ldsw + _i * 8192), 16, 0, 0); } while (0)
#define PG8_LDA(dst, b, h) do { _Pragma("unroll") for (int m = 0; m < 4; ++m) _Pragma("unroll") for (int k = 0; k < 2; ++k) dst[m][k] = *(const PG8_LAS bf16x8*)(lds + PG8_SA(b, h) + aoff + m * 2048 + k * 1024); } while (0)
#define PG8_LDB(dst, b, h) do { _Pragma("unroll") for (int n = 0; n < 2; ++n) _Pragma("unroll") for (int k = 0; k < 2; ++k) dst[n][k] = *(const PG8_LAS bf16x8*)(lds + PG8_SB(b, h) + boff + n * 2048 + k * 1024); } while (0)
#define PG8_MMA(ai, bj, At, Bt) do { __builtin_amdgcn_s_setprio(1); _Pragma("unroll") for (int m = 0; m < 4; ++m) _Pragma("unroll") for (int n = 0; n < 2; ++n) _Pragma("unroll") for (int k = 0; k < 2; ++k) \
        acc[ai][bj][m][n] = __builtin_amdgcn_mfma_f32_16x16x32_bf16(Bt[n][k], At[m][k], acc[ai][bj][m][n], 0, 0, 0); __builtin_amdgcn_s_setprio(0); } while (0)
#define PG8_WAIT_V(n) asm volatile("s_waitcnt vmcnt(" #n ")" ::: "memory")
#define PG8_WAIT_L(n) asm volatile("s_waitcnt lgkmcnt(" #n ")" ::: "memory")
#define PG8_BAR __builtin_amdgcn_s_barrier()
#define PG8_SCHED __builtin_amdgcn_sched_barrier(0)
    Unit cur, nxt; int ui = 0;
    if (!S.next(0, cur)) return;
    f32x4 acc[2][2][4][2];
#pragma unroll
    for (int a = 0; a < 2; ++a)
#pragma unroll
        for (int b = 0; b < 2; ++b)
#pragma unroll
            for (int m = 0; m < 4; ++m)
#pragma unroll
                for (int n = 0; n < 2; ++n) acc[a][b][m][n] = (f32x4){0.f, 0.f, 0.f, 0.f};
    bf16x8 At[4][2], B0[2][2], B1[2][2];
    const char* cA = (const char*)g.A + (size_t)cur.pm * tstep; const char* cB = (const char*)g.Bt + (size_t)cur.pn * tstep;
    S.a_ready(cur);
    if constexpr (SP2) {
        PG8_STAGE(PG8_SB(0, 0), cB, voffB); PG8_STAGE(PG8_SB(0, 1), cB + hstep, voffB); PG8_STAGE(PG8_SA(0, 0), cA, voffA); PG8_STAGE(PG8_SA(0, 1), cA + hstep, voffA);
        if (wr == 1) PG8_BAR;
        PG8_WAIT_V(2); PG8_BAR;
        PG8_STAGE(PG8_SB(1, 0), cB + kstep, voffB); PG8_STAGE(PG8_SA(1, 0), cA + kstep, voffA); PG8_STAGE(PG8_SB(1, 1), cB + hstep + kstep, voffB);
        PG8_WAIT_V(6); PG8_BAR;
    } else {
        PG8_STAGE(PG8_SB(0, 0), cB, voffB); PG8_STAGE(PG8_SA(0, 0), cA, voffA); PG8_STAGE(PG8_SB(0, 1), cB + hstep, voffB); PG8_STAGE(PG8_SA(0, 1), cA + hstep, voffA);
        if (wr == 1) PG8_BAR;
        PG8_WAIT_V(4); PG8_BAR;
        PG8_STAGE(PG8_SB(1, 0), cB + kstep, voffB); PG8_STAGE(PG8_SA(1, 0), cA + kstep, voffA); PG8_STAGE(PG8_SB(1, 1), cB + hstep + kstep, voffB);
        PG8_WAIT_V(6); PG8_BAR;
    }
    for (;;) {
        const bool has_next = S.next(ui + 1, nxt);
        const char* nA = has_next ? (const char*)g.A + (size_t)nxt.pm * tstep : cA; const char* nB = has_next ? (const char*)g.Bt + (size_t)nxt.pn * tstep : cB;
        for (int t = 0; t < nt; t += 2) {
            const bool last = (t == nt - 2);
            const char* a1 = cA + (size_t)(t + 1) * kstep;
            const char* a2 = last ? nA : cA + (size_t)(t + 2) * kstep; const char* b2 = last ? nB : cB + (size_t)(t + 2) * kstep;
            const char* a3 = a2 + kstep; const char* b3 = b2 + kstep;
            if (last && has_next) S.a_ready(nxt);
            if constexpr (SP2) {
            PG8_LDB(B0, 0, 0); PG8_LDB(B1, 0, 1); PG8_SCHED; PG8_LDA(At, 0, 0); PG8_STAGE(PG8_SA(1, 1), a1 + hstep, voffA);
            PG8_WAIT_V(8); PG8_WAIT_L(0); PG8_BAR; PG8_MMA(0, 0, At, B0); PG8_MMA(0, 1, At, B1); PG8_BAR; PG8_SCHED;
            PG8_LDA(At, 0, 1); PG8_STAGE(PG8_SB(0, 0), b2, voffB); PG8_STAGE(PG8_SB(0, 1), b2 + hstep, voffB); PG8_STAGE(PG8_SA(0, 0), a2, voffA);
            PG8_WAIT_V(8); PG8_WAIT_L(0); PG8_BAR; PG8_MMA(1, 0, At, B0); PG8_MMA(1, 1, At, B1); PG8_BAR; PG8_SCHED;
            PG8_LDB(B0, 1, 0); PG8_LDB(B1, 1, 1); PG8_SCHED; PG8_LDA(At, 1, 0); PG8_STAGE(PG8_SA(0, 1), a2 + hstep, voffA);
            PG8_WAIT_V(8); PG8_WAIT_L(0); PG8_BAR; PG8_MMA(0, 0, At, B0); PG8_MMA(0, 1, At, B1); PG8_BAR; PG8_SCHED;
            PG8_LDA(At, 1, 1); PG8_STAGE(PG8_SB(1, 0), b3, voffB); PG8_STAGE(PG8_SB(1, 1), b3 + hstep, voffB); PG8_STAGE(PG8_SA(1, 0), a3, voffA);
            PG8_WAIT_V(8); PG8_WAIT_L(0); PG8_BAR; PG8_MMA(1, 0, At, B0); PG8_MMA(1, 1, At, B1); PG8_BAR; PG8_SCHED;
            } else {
            PG8_LDB(B0, 0, 0); PG8_SCHED; PG8_LDA(At, 0, 0); PG8_STAGE(PG8_SA(1, 1), a1 + hstep, voffA);
            PG8_WAIT_L(8); PG8_BAR; PG8_WAIT_L(0); PG8_MMA(0, 0, At, B0); PG8_BAR; PG8_SCHED;
            PG8_LDB(B1, 0, 1); PG8_STAGE(PG8_SB(0, 0), b2, voffB);
            PG8_BAR; PG8_WAIT_L(0); PG8_MMA(0, 1, At, B1); PG8_BAR;
            PG8_LDA(At, 0, 1); PG8_STAGE(PG8_SA(0, 0), a2, voffA);
            PG8_BAR; PG8_WAIT_L(0); PG8_MMA(1, 0, At, B0); PG8_BAR; PG8_SCHED;
            PG8_STAGE(PG8_SB(0, 1), b2 + hstep, voffB);
            PG8_WAIT_V(6); PG8_BAR; PG8_MMA(1, 1, At, B1); PG8_BAR;
            PG8_LDB(B0, 1, 0); PG8_SCHED; PG8_LDA(At, 1, 0); PG8_STAGE(PG8_SA(0, 1), a2 + hstep, voffA);
            PG8_WAIT_L(8); PG8_BAR; PG8_WAIT_L(0); PG8_MMA(0, 0, At, B0); PG8_BAR; PG8_SCHED;
            PG8_LDB(B1, 1, 1); PG8_STAGE(PG8_SB(1, 0), b3, voffB);
            PG8_BAR; PG8_WAIT_L(0); PG8_MMA(0, 1, At, B1); PG8_BAR;
            PG8_LDA(At, 1, 1); PG8_STAGE(PG8_SA(1, 0), a3, voffA);
            PG8_BAR; PG8_WAIT_L(0); PG8_MMA(1, 0, At, B0); PG8_BAR; PG8_SCHED;
            PG8_STAGE(PG8_SB(1, 1), b3 + hstep, voffB);
            PG8_WAIT_V(6); PG8_BAR; PG8_MMA(1, 1, At, B1); PG8_BAR;
            }
        }
        if constexpr (ALIGN_EPI) { if (wr == 0) PG8_BAR; }
        if constexpr (!Epi::AFTER_DRAIN) { E(acc, cur, wr, wc, fr, fq); S.done(cur); }
        if (!has_next) break;
#pragma unroll
        for (int a = 0; a < 2; ++a)
#pragma unroll
            for (int b = 0; b < 2; ++b)
#pragma unroll
                for (int m = 0; m < 4; ++m)
#pragma unroll
                    for (int n = 0; n < 2; ++n) acc[a][b][m][n] = (f32x4){0.f, 0.f, 0.f, 0.f};
        cur = nxt; cA = nA; cB = nB; ++ui;
        if constexpr (ALIGN_EPI) { if (wr == 1) PG8_BAR; }
    }
    PG8_WAIT_V(0);
    if constexpr (!ALIGN_EPI) { if (wr == 0) PG8_BAR; }
    PG8_BAR;
    if constexpr (Epi::AFTER_DRAIN) { E.fused(acc, cur, wr, wc, fr, fq, lds, wid, lane); S.done(cur); }
#undef PG8_SA
#undef PG8_SB
#undef PG8_STAGE
#undef PG8_LDA
#undef PG8_LDB
#undef PG8_MMA
#undef PG8_WAIT_V
#undef PG8_WAIT_L
#undef PG8_BAR
#undef PG8_SCHED
}
}
#include <hip/hip_bf16.h>
namespace attn_body {
using bf16=__hip_bfloat16;
using bf16x8=__attribute__((ext_vector_type(8)))short;
using s16x4=__attribute__((ext_vector_type(4)))short;
using f32x16=__attribute__((ext_vector_type(16)))float;
using u32x4=__attribute__((ext_vector_type(4)))unsigned;
constexpr int BATCH=4,NHEAD=32,SEQ=8192,D=64,QP=1024,KP=64,VP=64,OP=2048;
constexpr int NW=8,QBLK=32,QB=QBLK*NW,KVBLK=64,NQB=SEQ/QB;
constexpr int ATTN_UNIT_ROWS=QB;
__device__ __forceinline__ int crow(int r,int hi){return (r&3)+8*(r>>2)+4*hi;}
#define SBAR() __builtin_amdgcn_sched_barrier(0)
__device__ __forceinline__ void cmask(f32x16&p0,f32x16&p1,int jb,int qrel,int hi){
  const float NEG=-INFINITY; int kb=64*jb+4*hi;
  #pragma unroll
  for(int r=0;r<16;++r){int kv=kb+(r&3)+8*(r>>2); if(kv>qrel)p0[r]=NEG; if(kv+32>qrel)p1[r]=NEG;}
}

__device__ __forceinline__ void addbias(f32x16&p0,f32x16&p1,const __attribute__((address_space(3))) float* tb){
  #pragma unroll
  for(int r=0;r<16;++r){ p0[r]+=tb[-((r&3)+8*(r>>2))]; p1[r]+=tb[-((r&3)+8*(r>>2))-32]; }
}
constexpr int NSLOT=3, SLOTB=8192;
constexpr int LDS_K=0, LDS_V=NSLOT*SLOTB, LDS_WS=2*NSLOT*SLOTB, LDS_OST=LDS_WS+NW*64*4, LDS_BYTES=LDS_OST+NW*4096;
constexpr float C2=0.125f*1.4426950408889634f;
__device__ __forceinline__ void glds16(const void*gsrc,unsigned lds_dst){unsigned keep;
  asm volatile("s_mov_b32 %0, m0\n\ts_mov_b32 m0, %2\n\ts_nop 0\n\tglobal_load_lds_dwordx4 %1, off\n\ts_mov_b32 m0, %0":"=&s"(keep):"v"(gsrc),"s"(lds_dst):"memory");}
__device__ __forceinline__ float max3f(float a,float b,float c){float r;asm("v_max3_f32 %0, %1, %2, %3":"=v"(r):"v"(a),"v"(b),"v"(c));return r;}
__device__ __forceinline__ float max2f(float a,float b){float r;asm("v_max_f32_e32 %0, %1, %2":"=v"(r):"v"(a),"v"(b));return r;}
__device__ __forceinline__ float fadd_s(float a,float b){float r;asm("v_add_f32_e32 %0, %1, %2":"=v"(r):"v"(a),"v"(b));return r;}
__device__ __forceinline__ float fsub_s(float a,float b){float r;asm("v_sub_f32_e32 %0, %1, %2":"=v"(r):"v"(a),"v"(b));return r;}
typedef float f32x2_t __attribute__((ext_vector_type(2))); typedef __bf16 bf16x2_t __attribute__((ext_vector_type(2)));
__device__ __forceinline__ unsigned cvtpk_s(float lo,float hi){f32x2_t v={lo,hi};bf16x2_t b=__builtin_convertvector(v,bf16x2_t);return __builtin_bit_cast(unsigned,b);}
#define WAIT_BAR(N) asm volatile("s_waitcnt vmcnt(" #N ") lgkmcnt(0)\n\ts_nop 15\n\ts_nop 15\n\ts_barrier\n\ts_nop 15\n\ts_nop 15":::"memory")

__device__ __forceinline__ void qkt(f32x16&p0,f32x16&p1,const char*Kslot,const bf16x8*qr,const f32x16&negm,int r32,int hi){
  const char*kb=Kslot+hi*1024+r32*16;
  #pragma unroll
  for(int d0=0;d0<4;++d0){
    const bf16x8 b0=*reinterpret_cast<const bf16x8*>(kb+d0*2048);
    const bf16x8 b1=*reinterpret_cast<const bf16x8*>(kb+d0*2048+512);
    if(d0==0){p0=__builtin_amdgcn_mfma_f32_32x32x16_bf16(b0,qr[0],negm,0,0,0);p1=__builtin_amdgcn_mfma_f32_32x32x16_bf16(b1,qr[0],negm,0,0,0);}
    else{p0=__builtin_amdgcn_mfma_f32_32x32x16_bf16(b0,qr[d0],p0,0,0,0);p1=__builtin_amdgcn_mfma_f32_32x32x16_bf16(b1,qr[d0],p1,0,0,0);}}
}
typedef __attribute__((address_space(3))) const char* lds_cptr;
typedef short v4i16_t __attribute__((ext_vector_type(4)));
__device__ __forceinline__ void kload8(bf16x8*kf,lds_cptr kp){
  kf[0]=*(const __attribute__((address_space(3))) bf16x8*)(kp);      kf[1]=*(const __attribute__((address_space(3))) bf16x8*)(kp+512);
  kf[2]=*(const __attribute__((address_space(3))) bf16x8*)(kp+2048); kf[3]=*(const __attribute__((address_space(3))) bf16x8*)(kp+2560);
  kf[4]=*(const __attribute__((address_space(3))) bf16x8*)(kp+4096); kf[5]=*(const __attribute__((address_space(3))) bf16x8*)(kp+4608);
  kf[6]=*(const __attribute__((address_space(3))) bf16x8*)(kp+6144); kf[7]=*(const __attribute__((address_space(3))) bf16x8*)(kp+6656);
}
__device__ __forceinline__ void kload2(bf16x8*kf,lds_cptr kp,int j){ kf[2*j]=*(const __attribute__((address_space(3))) bf16x8*)(kp+j*2048); kf[2*j+1]=*(const __attribute__((address_space(3))) bf16x8*)(kp+j*2048+512); }
__device__ __forceinline__ s16x4 vtr(lds_cptr p){ return __builtin_bit_cast(s16x4,__builtin_amdgcn_ds_read_tr16_b64_v4i16((__attribute__((address_space(3))) v4i16_t*)p)); }
__device__ __forceinline__ float rowmax(const f32x16&p0,const f32x16&p1){
  float a=max3f(p0[0],p0[1],p1[0]),b=max3f(p0[2],p0[3],p1[1]);a=max3f(a,p1[2],p1[3]);
  #pragma unroll
  for(int r=4;r<16;r+=4){a=max3f(a,p0[r],p0[r+1]);b=max3f(b,p0[r+2],p0[r+3]);a=max3f(a,p1[r],p1[r+1]);b=max3f(b,p1[r+2],p1[r+3]);}
  const float m=max2f(a,b);
  auto rr=__builtin_amdgcn_permlane32_swap(__float_as_uint(m),__float_as_uint(m),false,false);
  return max2f(__uint_as_float(rr[0]),__uint_as_float(rr[1]));
}
__device__ __forceinline__ void pv(f32x16*o,int vb,bf16x8 pa0,bf16x8 pa1,bf16x8 pa2,bf16x8 pa3){
  #pragma unroll
  for(int d0=0;d0<2;++d0){s16x4 lo[4],hi[4];
    #pragma unroll
    for(int ks=0;ks<4;++ks){
      asm volatile("ds_read_b64_tr_b16 %0,%1 offset:%c2":"=&v"(lo[ks]):"v"(vb),"i"(d0*4096+ks*1024):"memory");
      asm volatile("ds_read_b64_tr_b16 %0,%1 offset:%c2":"=&v"(hi[ks]):"v"(vb),"i"(d0*4096+ks*1024+512):"memory");}
    asm volatile("s_waitcnt lgkmcnt(0)":::"memory");SBAR();
    #define PK(k) (bf16x8){lo[k][0],lo[k][1],lo[k][2],lo[k][3],hi[k][0],hi[k][1],hi[k][2],hi[k][3]}
    o[d0]=__builtin_amdgcn_mfma_f32_32x32x16_bf16(pa0,PK(0),o[d0],0,0,0);
    o[d0]=__builtin_amdgcn_mfma_f32_32x32x16_bf16(pa1,PK(1),o[d0],0,0,0);
    o[d0]=__builtin_amdgcn_mfma_f32_32x32x16_bf16(pa2,PK(2),o[d0],0,0,0);
    o[d0]=__builtin_amdgcn_mfma_f32_32x32x16_bf16(pa3,PK(3),o[d0],0,0,0);
    #undef PK
  }
}

#ifndef ATTN_STORE16
#define ATTN_STORE16(p,v) (*(u32x4*)(p)=(v))
#endif
template<int THRL> __device__ __forceinline__ void attn_unit(int b,int vh,int qb,const bf16*Q,const bf16*__restrict__ K,const bf16*__restrict__ V,bf16*O,const float*btab,char*shm,int wave_s){
  const int h=vh>>2,jm=(vh>>1)&1,cv=vh&1;
  const int tid=fresh_tid(wave_s),lane=tid&63,r32=lane&31,hi=lane>>5; const int wid=wave_s;
  const long rowbase=(long)b*SEQ; const int q0=qb*QB;
  const bf16*Qw=Q+(rowbase+q0+wid*QBLK)*QP+jm*512+h*64;
  const bf16*Kh=K+(long)((jm*BATCH+b)*8+h)*SEQ*64,*Vh=V+(long)((b*8+h)*2+cv)*SEQ*64;
  const unsigned lds0=(unsigned)(uintptr_t)shm;
  float*wsf=(float*)(shm+LDS_WS)+wid*64;
  const bf16*ksrc=Kh+(long)lane*KP+wid*8;
  const bf16*vsrc=Vh+(long)(16*(wid&3)+(lane>>2))*VP+(wid>>2)*32+(lane&3)*8;
  const unsigned kdst=lds0+LDS_K+wid*1024, vdst=lds0+LDS_V+wid*1024;
  #define DMA_K(t,slot) glds16(ksrc+(long)(t)*KVBLK*KP,(unsigned)__builtin_amdgcn_readfirstlane(kdst+(slot)))
  #define DMA_V(t,slot) glds16(vsrc+(long)(t)*KVBLK*VP,(unsigned)__builtin_amdgcn_readfirstlane(vdst+(slot)))
  const int vb0=(int)(lds0+LDS_V)+((lane>>4)&1)*32+(lane&3)*8+(4*hi+((lane&15)>>2))*64;
  const char*Kbase=shm+LDS_K; bf16x8 kf[8];
  const lds_cptr shm3=(lds_cptr)shm; const lds_cptr kp0=shm3+LDS_K+hi*1024+r32*16; const lds_cptr vp0=shm3+LDS_V+((lane>>4)&1)*32+(lane&3)*8+(4*hi+((lane&15)>>2))*64;
  const __attribute__((address_space(3))) float* tabL=(const __attribute__((address_space(3))) float*)(shm3+LDS_BYTES);
  { __attribute__((address_space(3))) float* tw=(__attribute__((address_space(3))) float*)(shm3+LDS_BYTES); const int d_=tid-256; tw[tid]=(d_>=0&&d_<128)?btab[h*128+d_]:0.f; if(tid<256)tw[512+tid]=0.f; }
  const int NT=(q0+QB)/KVBLK;
  DMA_K(0,0);DMA_V(0,0);DMA_K(1,SLOTB);
  bf16x8 qr[4];
  #pragma unroll
  for(int d0=0;d0<4;++d0)qr[d0]=*reinterpret_cast<const bf16x8*>(&Qw[(long)r32*QP+d0*16+hi*8]);
  float mhat=0.f,l_reg=0.f;f32x16 o[2];o[0]=f32x16{};o[1]=f32x16{};f32x16 negm=f32x16{};asm volatile("":"+v"(negm));
  const int qrel=wid*QBLK+r32;
  #define CMASK(P0,P1,t) do{ if((t)>=NT-6+(wid>>1)&&(t)<=NT-4+(wid>>1)) addbias(P0,P1,tabL+(256+q0+qrel-64*(t)-4*hi)); int jb_=(t)-(NT-4); if(jb_>=0)cmask(P0,P1,jb_,qrel,hi);}while(0)
  bool resc=false;
  #define START(P0,P1) do{ const float rm=rowmax(P0,P1); resc=false; \
    { const float dl=rm; mhat=fadd_s(mhat,dl); \
      _Pragma("unroll") for(int r=0;r<16;++r){P0[r]=fsub_s(P0[r],dl);P1[r]=fsub_s(P1[r],dl);} \
      _Pragma("unroll") for(int r=0;r<16;++r)negm[r]=-mhat; asm volatile("":"+v"(negm)); } \
    _Pragma("unroll") for(int r=0;r<16;++r)P0[r]=__builtin_amdgcn_exp2f(P0[r]); }while(0)
  #define RESC() do{ if(resc){ asm volatile("s_waitcnt lgkmcnt(0)":::"memory"); \
      _Pragma("unroll") for(int d_=0;d_<2;++d_) _Pragma("unroll") for(int r=0;r<16;++r)o[d_][r]*=wsf[crow(r,hi)]; } }while(0)
  f32x16 pA0,pA1,pB0,pB1;
  int sl_prev=0,sl_cur=0,sl_next=SLOTB;
  #define ROT() do{sl_prev=sl_cur;sl_cur=sl_next;sl_next=(sl_next==(NSLOT-1)*SLOTB)?0:sl_next+SLOTB;}while(0)
  DMA_K(2,2*SLOTB);
  WAIT_BAR(3);
  qkt(pA0,pA1,Kbase,qr,negm,r32,hi);asm volatile("s_nop 15\n\ts_nop 7":"+v"(pA0),"+v"(pA1));CMASK(pA0,pA1,0);
  START(pA0,pA1);
  _Pragma("unroll") for(int r=0;r<16;++r)pA1[r]=__builtin_amdgcn_exp2f(pA1[r]);
  WAIT_BAR(0);
  DMA_K(3,0);DMA_V(1,SLOTB);
  ROT();
  kload8(kf,kp0+sl_cur);
  WAIT_BAR(2);
  s16x4 vlo[8],vhi[8]; u32x4 pw0,pw1,pw2,pw3;
  #define PKW(P,B) cvtpk_s(P[B],P[B+1])
  #define PAF(k) __builtin_bit_cast(bf16x8,pw##k)
  #define VFR(i) (bf16x8){vlo[i][0],vlo[i][1],vlo[i][2],vlo[i][3],vhi[i][0],vhi[i][1],vhi[i][2],vhi[i][3]}
  #define PIN(x) asm volatile("":"+v"(x))
  #define MX3(a,b,c) __builtin_fmaxf(__builtin_fmaxf((a),(b)),(c))
  #define GAPA(MF,A0,A1,A2,A3,W0,W1,PW) do{ MF; sacc+=A0; sacc+=A1; sacc+=A2; sacc+=A3; PIN(sacc); W0; W1; PIN(PW); SBAR(); }while(0)
  #define EX(v) __builtin_amdgcn_exp2f(v)
  #define GAPB(MF,X,B) do{ MF; X[B]=EX(X[B]); X[B+1]=EX(X[B+1]); X[B+2]=EX(X[B+2]); X[B+3]=EX(X[B+3]); PIN(X); SBAR(); }while(0)
  #define VRD(i) do{ vlo[i]=vtr(vp_+(((i)>>2)*4096+((i)&3)*1024)); vhi[i]=vtr(vp_+(((i)>>2)*4096+((i)&3)*1024+512)); }while(0)
  #define KRD(G,j) do{ if(G){ kload2(kf,kp0+sl_next,j); SBAR(); } }while(0)
  #define STEP(C0,C1,P0,P1,t,GK,GV,GL) do{ SBAR(); \
    const lds_cptr vp_=vp0+sl_prev; \
    VRD(0); SBAR(); float sacc=(P0[0]+P0[1]); \
    GAPA(C0=__builtin_amdgcn_mfma_f32_32x32x16_bf16(kf[0],qr[0],negm,0,0,0), P0[2],P0[3],P0[4],P0[5],     pw0[0]=PKW(P0,0), pw0[1]=PKW(P0,2), pw0); \
    VRD(4); SBAR(); GAPA(C1=__builtin_amdgcn_mfma_f32_32x32x16_bf16(kf[1],qr[0],negm,0,0,0), P0[6],P0[7],P0[8],P0[9],     pw0[2]=PKW(P0,4), pw0[3]=PKW(P0,6), pw0); \
    VRD(1); SBAR(); GAPA(C0=__builtin_amdgcn_mfma_f32_32x32x16_bf16(kf[2],qr[1],C0,0,0,0),   P0[10],P0[11],P0[12],P0[13], pw1[0]=PKW(P0,8), pw1[1]=PKW(P0,10), pw1); \
    VRD(5); SBAR(); GAPA(C1=__builtin_amdgcn_mfma_f32_32x32x16_bf16(kf[3],qr[1],C1,0,0,0),   P0[14],P0[15],P1[0],P1[1],   pw1[2]=PKW(P0,12),pw1[3]=PKW(P0,14), pw1); \
    VRD(2); SBAR(); GAPA(C0=__builtin_amdgcn_mfma_f32_32x32x16_bf16(kf[4],qr[2],C0,0,0,0),   P1[2],P1[3],P1[4],P1[5],     pw2[0]=PKW(P1,0), pw2[1]=PKW(P1,2), pw2); \
    VRD(6); SBAR(); GAPA(C1=__builtin_amdgcn_mfma_f32_32x32x16_bf16(kf[5],qr[2],C1,0,0,0),   P1[6],P1[7],P1[8],P1[9],     pw2[2]=PKW(P1,4), pw2[3]=PKW(P1,6), pw2); \
    VRD(3); SBAR(); GAPA(C0=__builtin_amdgcn_mfma_f32_32x32x16_bf16(kf[6],qr[3],C0,0,0,0),   P1[10],P1[11],P1[12],P1[13], pw3[0]=PKW(P1,8), pw3[1]=PKW(P1,10), pw3); \
    VRD(7); SBAR(); GAPA(C1=__builtin_amdgcn_mfma_f32_32x32x16_bf16(kf[7],qr[3],C1,0,0,0),   P1[14],P1[15],0.f,0.f,       pw3[2]=PKW(P1,12),pw3[3]=PKW(P1,14), pw3); \
    l_reg+=sacc; \
    if(GK){DMA_K((t)+3,sl_cur);} if(GV){DMA_V((t)+1,sl_next);} \
    CMASK(C0,C1,t); \
    { float a=MX3(C0[0],C0[1],C1[0]),b=MX3(C0[2],C0[3],C1[1]); a=MX3(a,C1[2],C1[3]); \
      _Pragma("unroll") for(int r=4;r<16;r+=4){a=MX3(a,C0[r],C0[r+1]);b=MX3(b,C0[r+2],C0[r+3]);a=MX3(a,C1[r],C1[r+1]);b=MX3(b,C1[r+2],C1[r+3]);} \
      float rm=__builtin_fmaxf(a,b); { auto rr=__builtin_amdgcn_permlane32_swap(__float_as_uint(rm),__float_as_uint(rm),false,false); rm=__builtin_fmaxf(__uint_as_float(rr[0]),__uint_as_float(rr[1])); } \
      resc=false; \
      if(__builtin_expect(__any(rm>(float)THRL),0)){ const float dl=__builtin_fmaxf(rm,0.f); mhat+=dl; \
        _Pragma("unroll") for(int r=0;r<16;++r){C0[r]-=dl;C1[r]-=dl;} \
        _Pragma("unroll") for(int r=0;r<16;++r)negm[r]=-mhat; asm volatile("":"+v"(negm)); \
        const float f=__builtin_amdgcn_exp2f(-dl); l_reg*=f; if(hi==0)wsf[r32]=f; resc=true; } } \
    SBAR(); \
    GAPB(o[0]=__builtin_amdgcn_mfma_f32_32x32x16_bf16(PAF(0),VFR(0),o[0],0,0,0), C0,0); \
    GAPB(o[1]=__builtin_amdgcn_mfma_f32_32x32x16_bf16(PAF(0),VFR(4),o[1],0,0,0), C0,4); \
    KRD(GL,0); GAPB(o[0]=__builtin_amdgcn_mfma_f32_32x32x16_bf16(PAF(1),VFR(1),o[0],0,0,0), C0,8); \
    KRD(GL,1); GAPB(o[1]=__builtin_amdgcn_mfma_f32_32x32x16_bf16(PAF(1),VFR(5),o[1],0,0,0), C0,12); \
    KRD(GL,2); GAPB(o[0]=__builtin_amdgcn_mfma_f32_32x32x16_bf16(PAF(2),VFR(2),o[0],0,0,0), C1,0); \
    KRD(GL,3); GAPB(o[1]=__builtin_amdgcn_mfma_f32_32x32x16_bf16(PAF(2),VFR(6),o[1],0,0,0), C1,4); \
    GAPB(o[0]=__builtin_amdgcn_mfma_f32_32x32x16_bf16(PAF(3),VFR(3),o[0],0,0,0), C1,8); \
    GAPB(o[1]=__builtin_amdgcn_mfma_f32_32x32x16_bf16(PAF(3),VFR(7),o[1],0,0,0), C1,12); \
    }while(0)
  int t=1;
  #undef CMASK
  #define CMASK(P0,P1,t) do{}while(0)
  for(;t+7<NT;t+=2){
    STEP(pB0,pB1,pA0,pA1,t,true,true,true);     WAIT_BAR(2); RESC(); ROT();
    STEP(pA0,pA1,pB0,pB1,t+1,true,true,true);   WAIT_BAR(2); RESC(); ROT();
  }
  #undef CMASK
  #define CMASK(P0,P1,t) do{ if((t)>=NT-6+(wid>>1)&&(t)<=NT-4+(wid>>1)) addbias(P0,P1,tabL+(256+q0+qrel-64*(t)-4*hi)); int jb_=(t)-(NT-4); if(jb_>=0)cmask(P0,P1,jb_,qrel,hi);}while(0)
  #define ENDW(tt) do{ if((tt)+3<NT){WAIT_BAR(2);} else if((tt)+2<NT){WAIT_BAR(1);} else {WAIT_BAR(0);} }while(0)
  for(;t+1<NT;t+=2){
    STEP(pB0,pB1,pA0,pA1,t,(t+3<NT),(t+1<NT),(t+1<NT));       ENDW(t);   RESC(); ROT();
    STEP(pA0,pA1,pB0,pB1,t+1,(t+4<NT),(t+2<NT),(t+2<NT));     ENDW(t+1); RESC(); ROT();
  }
  STEP(pB0,pB1,pA0,pA1,NT-1,false,false,false); RESC();
  { float sacc=pB0[0]+pB0[1]; _Pragma("unroll") for(int r=2;r<16;++r)sacc+=pB0[r]; _Pragma("unroll") for(int r=0;r<16;++r)sacc+=pB1[r]; l_reg+=sacc;
    pw0=(u32x4){PKW(pB0,0),PKW(pB0,2),PKW(pB0,4),PKW(pB0,6)};pw1=(u32x4){PKW(pB0,8),PKW(pB0,10),PKW(pB0,12),PKW(pB0,14)};pw2=(u32x4){PKW(pB1,0),PKW(pB1,2),PKW(pB1,4),PKW(pB1,6)};pw3=(u32x4){PKW(pB1,8),PKW(pB1,10),PKW(pB1,12),PKW(pB1,14)};
    SBAR(); pv(o,vb0+sl_cur,PAF(0),PAF(1),PAF(2),PAF(3)); }
  #undef PKW
  #undef PAF
  #undef VFR
  #undef PIN
  #undef MX3
  #undef GAPA
  #undef GAPB
  #undef EX
  #undef VRD
  #undef KRD
  #undef STEP
  #undef ENDW
  {auto rr=__builtin_amdgcn_permlane32_swap(__float_as_uint(l_reg),__float_as_uint(l_reg),false,false);l_reg=__uint_as_float(rr[0])+__uint_as_float(rr[1]);}
  if(hi==0)wsf[32+r32]=l_reg;asm volatile("s_waitcnt lgkmcnt(0)":::"memory");
  float rli[16];
  #pragma unroll
  for(int r=0;r<16;++r)rli[r]=__builtin_amdgcn_rcpf(wsf[32+crow(r,hi)]);
  bf16*Ow=O+(rowbase+q0+wid*QBLK)*OP+jm*1024+h*128+cv*64;
  { bf16*stg=(bf16*)(shm+LDS_OST)+wid*2048;
    #pragma unroll
    for(int r=0;r<16;++r){const int orow=crow(r,hi);
      #pragma unroll
      for(int d0=0;d0<2;++d0)stg[orow*64+d0*32+r32]=__float2bfloat16(o[d0][r]*rli[r]);}
    asm volatile("s_waitcnt lgkmcnt(0)":::"memory");
    #pragma unroll
    for(int i=0;i<4;++i){const int row=i*8+(lane>>3),ch=lane&7; const u32x4 v=*(const u32x4*)(stg+row*64+ch*8); ATTN_STORE16(Ow+(long)row*OP+ch*8,v);} }
  asm volatile("s_waitcnt lgkmcnt(0)\n\ts_barrier":::"memory");
  #undef DMA_K
  #undef DMA_V
  #undef CMASK
  #undef START
  #undef RESC
  #undef ROT
}
constexpr int ATTN_LDS_BYTES=LDS_BYTES;
struct AttnTensors { const bf16* Q; const bf16* K; const bf16* V; bf16* O; const float* btab; };
struct AttnUnit { int bh; int qb; };
struct StaticOrder {
  int vcu;
  __device__ __forceinline__ explicit StaticOrder(int grid,int block):vcu((block%8)*(grid/8)+block/8){}
  __device__ __forceinline__ bool next(int i,AttnUnit&u)const{ if(i>=16)return false; const int s=vcu&7,ii=i&3; u.bh=(vcu>>3)+32*(i>>2); u.qb=(ii==0)?s:(ii==1)?15-s:(ii==2)?16+s:31-s; return true; }
  __device__ __forceinline__ void a_ready(const AttnUnit&)const{}
  __device__ __forceinline__ void done(const AttnUnit&)const{}
};
template<class Sched,int THRL=8> __device__ __forceinline__ void attn_phase(char*lds,const AttnTensors&T,const Sched&S,int wave_s){
  AttnUnit u;
  for(int i=0;S.next(i,u);++i){ S.a_ready(u); attn_unit<THRL>(u.bh/NHEAD,u.bh%NHEAD,u.qb,T.Q,T.K,T.V,T.O,T.btab,lds,wave_s); S.done(u); }
}
#undef SBAR
#undef WAIT_BAR
}
#define LAS __attribute__((address_space(3)))
typedef unsigned short bf16_t;
typedef short bf16x8 __attribute__((ext_vector_type(8)));
typedef float f32x4 __attribute__((ext_vector_type(4)));
typedef float f32x16 __attribute__((ext_vector_type(16)));
typedef unsigned u32x4 __attribute__((ext_vector_type(4)));
typedef unsigned u32x2 __attribute__((ext_vector_type(2)));
typedef float f32x2_t __attribute__((ext_vector_type(2)));
typedef __bf16 bf16x2_t __attribute__((ext_vector_type(2)));

constexpr int BATCH = 4, SEQ = 8192, DM = 1024, MTOK = BATCH * SEQ, DFF = 2816, NFF = 2 * DFF;
constexpr float EPS = 1e-6f, LOG2E = 1.4426950408889634f;
constexpr float LAMBDA_INIT = 0.35550906f;
constexpr float QSCALE = 0.125f * LOG2E;
constexpr int NWAVES = 8, NTHR = 512;
constexpr int LDS_BYTES = 139264;

constexpr size_t MiB = 1u << 20;
constexpr size_t WS_SSQ = 496 * MiB;
constexpr size_t WS_LB = 1 * MiB;
constexpr size_t WS_BTAB = 1 * MiB + 4096;
constexpr size_t WS_LAM = 1 * MiB + 8192;
constexpr size_t WS_FI00 = 2 * MiB, WS_FI01 = 13 * MiB, WS_FO00 = 24 * MiB, WS_FO01 = 24 * MiB + 5632 * 1024, WS_HIN = 35 * MiB, WS_HOUT = 43 * MiB;
constexpr size_t WS_HB = 45 * MiB;
constexpr size_t WS_BIG = 109 * MiB;
constexpr size_t WS_HID = WS_BIG;
constexpr size_t WS_QH = WS_BIG, WS_LF = WS_BIG + 64 * MiB, WS_VH = WS_BIG + 128 * MiB, WS_GH = WS_BIG + 192 * MiB, WS_UT = WS_BIG + 256 * MiB, WS_DEC = WS_BIG + 384 * MiB;
constexpr size_t WS_W1 = 302 * MiB;
constexpr size_t WS_FI10 = WS_W1, WS_FI11 = WS_W1 + 11 * MiB, WS_FO10 = WS_W1 + 22 * MiB, WS_FO11 = WS_W1 + 22 * MiB + 5632 * 1024, WS_WKV = WS_W1 + 33 * MiB, WS_WQ = WS_W1 + 37 * MiB, WS_WAO = WS_W1 + 39 * MiB;
constexpr size_t WS_KV = 361 * MiB;
constexpr size_t WS_QB = WS_BIG;
constexpr size_t WS_OB = WS_BIG + 64 * MiB;
constexpr size_t WS_END = 511 * MiB;
static_assert(WS_DEC + 2 * MiB <= WS_SSQ && WS_KV + 128 * MiB <= WS_SSQ && WS_SSQ + (size_t)7 * MTOK * 64 <= WS_END && WS_OB + 128 * MiB <= WS_W1 && WS_WAO + 2 * MiB <= WS_KV && WS_HID + (size_t)MTOK * DFF * 2 <= WS_W1, "ws map");

__device__ __forceinline__ float bf2f(unsigned short b) { return __uint_as_float((unsigned)b << 16); }
__device__ __forceinline__ unsigned pkbf(float lo, float hi) { f32x2_t v = {lo, hi}; bf16x2_t b = __builtin_convertvector(v, bf16x2_t); return __builtin_bit_cast(unsigned, b); }
__device__ __forceinline__ unsigned short f2bf(float f) { return (unsigned short)(pkbf(f, 0.f) & 0xffffu); }
__device__ __forceinline__ float fexp(float x) { return __builtin_amdgcn_exp2f(x * LOG2E); }
__device__ __forceinline__ float sigm(float v) { return __builtin_amdgcn_rcpf(1.f + __builtin_amdgcn_exp2f(-v * LOG2E)); }
__device__ __forceinline__ float silu(float v) { return v * sigm(v); }
__device__ __forceinline__ float wave_sum(float v) {
#pragma unroll
    for (int o = 1; o < 64; o <<= 1) v += __shfl_xor(v, o);
    return v;
}
__device__ __forceinline__ int crow(int r, int hi) { return (r & 3) + 8 * (r >> 2) + 4 * hi; }

namespace epi {
using pg8::Unit;
__device__ __forceinline__ float rstd_of(const float* ssq, int row, int fq) {
    const f32x4 a = *(const f32x4*)(ssq + (size_t)row * 16 + fq * 4);
    float t = (a[0] + a[1]) + (a[2] + a[3]);
    t += __shfl_xor(t, 16); t += __shfl_xor(t, 32);
    return rsqrtf(t * (1.f / 1024.f) + EPS);
}

struct EpiSwiglu {
    static constexpr bool PERM = true, AFTER_DRAIN = false;
    bf16_t* H; const float* ssq;
    __device__ __forceinline__ void operator()(const f32x4 (&acc)[2][2][4][2], const Unit& u, int wr, int wc, int fr, int fq) const {
        const int col0 = u.pn * 128 + wc * 32 + 8 * fq;
#pragma unroll
        for (int ai = 0; ai < 2; ++ai)
#pragma unroll
            for (int m = 0; m < 4; ++m) {
                const int row = u.pm * 256 + ai * 128 + wr * 64 + m * 16 + fr; const float r = rstd_of(ssq, row, fq);
                float o[8];
#pragma unroll
                for (int n = 0; n < 2; ++n)
#pragma unroll
                    for (int e = 0; e < 4; ++e) { const float g = acc[ai][0][m][n][e] * r, uu = acc[ai][1][m][n][e] * r; o[n * 4 + e] = silu(g) * uu; }
                u32x4 w; w.x = pkbf(o[0], o[1]); w.y = pkbf(o[2], o[3]); w.z = pkbf(o[4], o[5]); w.w = pkbf(o[6], o[7]);
                *(u32x4*)(H + (size_t)row * DFF + col0) = w;
            }
    }
};
constexpr int LO_BITS = 8;
__device__ __forceinline__ float lo8_dec(unsigned hbits16, int q) {
    const unsigned eb = (hbits16 >> 7) & 0xffu; const float ulp = __uint_as_float(eb > 7u ? (eb - 7u) << 23 : 0u);
    return __uint_as_float(hbits16 << 16) + (float)q * ulp * (1.f / 254.f);
}
__device__ __forceinline__ unsigned lo8_enc(unsigned hbits16, float o) {
    const unsigned eb = (hbits16 >> 7) & 0xffu; const float inv = __uint_as_float(eb > 7u ? (261u - eb) << 23 : 0u);
    const float r = (o - __uint_as_float(hbits16 << 16)) * inv * 254.f;
    return (unsigned)(int)rintf(fminf(fmaxf(r, -127.f), 127.f)) & 0xffu;
}
template <bool BASE_F32, bool OUT_F32>
struct EpiRes {
    static constexpr bool PERM = true, AFTER_DRAIN = false;
    const float* basef; bf16_t* hi; unsigned char* lo; float* outf; float* ssq_out; float alpha;
    __device__ __forceinline__ void operator()(const f32x4 (&acc)[2][2][4][2], const Unit& u, int wr, int wc, int fr, int fq) const {
        const int col0 = u.pn * 256 + wc * 32 + 8 * fq;
#pragma unroll
        for (int ai = 0; ai < 2; ++ai)
#pragma unroll
            for (int m = 0; m < 4; ++m) {
                const int row = u.pm * 256 + ai * 128 + wr * 64 + m * 16 + fr; float s = 0.f;
#pragma unroll
                for (int bj = 0; bj < 2; ++bj) {
                    const size_t off = (size_t)row * DM + col0 + bj * 128;
                    float o[8];
                    if (BASE_F32) {
                        const f32x4 b0 = *(const f32x4*)(basef + off), b1 = *(const f32x4*)(basef + off + 4);
#pragma unroll
                        for (int e = 0; e < 4; ++e) { o[e] = b0[e]; o[4 + e] = b1[e]; }
                    } else {
                        const u32x4 hv = *(const u32x4*)(hi + off);
                        if (LO_BITS == 16) {
                            const u32x4 lv = *(const u32x4*)((const bf16_t*)lo + off);
#pragma unroll
                            for (int k = 0; k < 4; ++k) { o[2 * k] = __uint_as_float(hv[k] << 16) + __uint_as_float(lv[k] << 16); o[2 * k + 1] = __uint_as_float(hv[k] & 0xffff0000u) + __uint_as_float(lv[k] & 0xffff0000u); }
                        } else {
                            const u32x2 lv = *(const u32x2*)(lo + off);
#pragma unroll
                            for (int k = 0; k < 4; ++k) { const unsigned lw = k < 2 ? lv.x : lv.y; const int sh = (k & 1) * 16;
                                o[2 * k] = lo8_dec(hv[k] & 0xffffu, (int)(signed char)((lw >> sh) & 0xffu)); o[2 * k + 1] = lo8_dec(hv[k] >> 16, (int)(signed char)((lw >> (sh + 8)) & 0xffu)); }
                        }
                    }
#pragma unroll
                    for (int e = 0; e < 4; ++e) { o[e] += acc[ai][bj][m][0][e] * alpha; o[4 + e] += acc[ai][bj][m][1][e] * alpha; }
                    if (OUT_F32) {
                        *(f32x4*)(outf + off) = (f32x4){o[0], o[1], o[2], o[3]}; *(f32x4*)(outf + off + 4) = (f32x4){o[4], o[5], o[6], o[7]};
                    } else {
                        u32x4 hw; hw.x = pkbf(o[0], o[1]); hw.y = pkbf(o[2], o[3]); hw.z = pkbf(o[4], o[5]); hw.w = pkbf(o[6], o[7]);
                        *(u32x4*)(hi + off) = hw;
                        if (LO_BITS == 16) {
                            u32x4 lw;
#pragma unroll
                            for (int k = 0; k < 4; ++k) lw[k] = pkbf(o[2 * k] - __uint_as_float(hw[k] << 16), o[2 * k + 1] - __uint_as_float(hw[k] & 0xffff0000u));
                            *(u32x4*)((bf16_t*)lo + off) = lw;
                        } else {
                            unsigned q[8];
#pragma unroll
                            for (int k = 0; k < 4; ++k) { q[2 * k] = lo8_enc(hw[k] & 0xffffu, o[2 * k]); q[2 * k + 1] = lo8_enc(hw[k] >> 16, o[2 * k + 1]); }
                            u32x2 lw; lw.x = q[0] | (q[1] << 8) | (q[2] << 16) | (q[3] << 24); lw.y = q[4] | (q[5] << 8) | (q[6] << 16) | (q[7] << 24);
                            *(u32x2*)(lo + off) = lw;
                        }
                    }
                    s += (o[0] * o[0] + o[1] * o[1]) + (o[2] * o[2] + o[3] * o[3]) + (o[4] * o[4] + o[5] * o[5]) + (o[6] * o[6] + o[7] * o[7]);
                }
                s += __shfl_xor(s, 16); s += __shfl_xor(s, 32);
                if (fq == 0) ssq_out[(size_t)row * 16 + u.pn * 4 + wc] = s;
            }
    }
};
struct EpiBf16 {
    static constexpr bool PERM = true, AFTER_DRAIN = false;
    bf16_t* O; int ldc; const float* ssq; float scale;
    __device__ __forceinline__ void operator()(const f32x4 (&acc)[2][2][4][2], const Unit& u, int wr, int wc, int fr, int fq) const {
        const int col0 = u.pn * 256 + wc * 32 + 8 * fq;
#pragma unroll
        for (int ai = 0; ai < 2; ++ai)
#pragma unroll
            for (int m = 0; m < 4; ++m) {
                const int row = u.pm * 256 + ai * 128 + wr * 64 + m * 16 + fr; const float r = rstd_of(ssq, row, fq) * scale;
#pragma unroll
                for (int bj = 0; bj < 2; ++bj) {
                    const f32x4 v0 = acc[ai][bj][m][0] * r, v1 = acc[ai][bj][m][1] * r;
                    u32x4 w; w.x = pkbf(v0[0], v0[1]); w.y = pkbf(v0[2], v0[3]); w.z = pkbf(v1[0], v1[1]); w.w = pkbf(v1[2], v1[3]);
                    *(u32x4*)(O + (size_t)row * ldc + col0 + bj * 128) = w;
                }
            }
    }
};
struct EpiKV {
    static constexpr bool PERM = true, AFTER_DRAIN = false;
    bf16_t* KK; bf16_t* VV; const float* ssq;
    __device__ __forceinline__ void operator()(const f32x4 (&acc)[2][2][4][2], const Unit& u, int wr, int wc, int fr, int fq) const {
#pragma unroll
        for (int bj = 0; bj < 2; ++bj) {
            const int col = u.pn * 256 + bj * 128 + wc * 32 + 8 * fq;
            bf16_t* basep; size_t bstride;
            if (col < 1024) { const int j = col >> 9, h = (col >> 6) & 7; basep = KK + ((size_t)(j * BATCH * 8 + h) * SEQ) * 64 + (col & 63); bstride = (size_t)8 * SEQ * 64; }
            else { const int c2 = col - 1024, h = c2 >> 7, cv = (c2 >> 6) & 1; basep = VV + ((size_t)(h * 2 + cv) * SEQ) * 64 + (c2 & 63); bstride = (size_t)16 * SEQ * 64; }
#pragma unroll
            for (int ai = 0; ai < 2; ++ai)
#pragma unroll
                for (int m = 0; m < 4; ++m) {
                    const int row = u.pm * 256 + ai * 128 + wr * 64 + m * 16 + fr; const float r = rstd_of(ssq, row, fq);
                    const f32x4 v0 = acc[ai][bj][m][0] * r, v1 = acc[ai][bj][m][1] * r;
                    u32x4 w; w.x = pkbf(v0[0], v0[1]); w.y = pkbf(v0[2], v0[3]); w.z = pkbf(v1[0], v1[1]); w.w = pkbf(v1[2], v1[3]);
                    *(u32x4*)(basep + (size_t)(row >> 13) * bstride + (size_t)(row & (SEQ - 1)) * 64) = w;
                }
        }
    }
};
struct EpiHgrnIn {
    static constexpr bool PERM = true, AFTER_DRAIN = false;
    bf16_t* QH; unsigned short* LF; bf16_t* VH; bf16_t* GH; const float* ssq; const float* lb;
    __device__ __forceinline__ void operator()(const f32x4 (&acc)[2][2][4][2], const Unit& u, int wr, int wc, int fr, int fq) const {
        const int typ = u.pn >> 2; const int col0 = (u.pn & 3) * 256 + wc * 32 + 8 * fq;
        f32x4 lbv[2][2];
#pragma unroll
        for (int bj = 0; bj < 2; ++bj)
#pragma unroll
            for (int n = 0; n < 2; ++n) lbv[bj][n] = (typ == 1) ? *(const f32x4*)(lb + col0 + bj * 128 + 4 * n) : (f32x4){0.f, 0.f, 0.f, 0.f};
        bf16_t* dst = typ == 0 ? QH : (typ == 1 ? (bf16_t*)LF : (typ == 2 ? VH : GH));
#pragma unroll
        for (int ai = 0; ai < 2; ++ai)
#pragma unroll
            for (int m = 0; m < 4; ++m) {
                const int row = u.pm * 256 + ai * 128 + wr * 64 + m * 16 + fr; const float r = rstd_of(ssq, row, fq);
#pragma unroll
                for (int bj = 0; bj < 2; ++bj) {
                    const f32x4 v0 = acc[ai][bj][m][0] * r, v1 = acc[ai][bj][m][1] * r;
                    u32x4 w;
                    if (typ == 1) {
                        unsigned q[8];
#pragma unroll
                        for (int e = 0; e < 8; ++e) { const float x = e < 4 ? v0[e & 3] : v1[e & 3]; const float l = e < 4 ? lbv[bj][0][e & 3] : lbv[bj][1][e & 3];
                            const float f = l + (1.f - l) * sigm(x); const float nl = -__logf(f) * 32768.f; q[e] = (unsigned)fminf(fmaxf(rintf(nl), 0.f), 65535.f); }
                        w.x = q[0] | (q[1] << 16); w.y = q[2] | (q[3] << 16); w.z = q[4] | (q[5] << 16); w.w = q[6] | (q[7] << 16);
                    } else if (typ == 2) {
                        w.x = pkbf(v0[0], v0[1]); w.y = pkbf(v0[2], v0[3]); w.z = pkbf(v1[0], v1[1]); w.w = pkbf(v1[2], v1[3]);
                    } else {
                        w.x = pkbf(silu(v0[0]), silu(v0[1])); w.y = pkbf(silu(v0[2]), silu(v0[3])); w.z = pkbf(silu(v1[0]), silu(v1[1])); w.w = pkbf(silu(v1[2]), silu(v1[3]));
                    }
                    *(u32x4*)(dst + (size_t)row * DM + col0 + bj * 128) = w;
                }
            }
    }
};
}

__device__ __forceinline__ int swmap(int n) { return n < DFF ? ((n >> 7) * 256 + (n & 127)) : (((n - DFF) >> 7) * 256 + 128 + ((n - DFF) & 127)); }
__device__ __forceinline__ void transpose_item(const float* W, int K, int N, bf16_t* WT, const float* nw, int mode, LAS float* scr, int item, int lane) {
    const int nblk = N / 32, kb = item / nblk, nb = item % nblk, k0 = 64 * kb, n0 = 32 * nb;
#pragma unroll 8
    for (int i = 0; i < 32; ++i) { const int kk = 2 * i + (lane >> 5); float v = W[(size_t)(k0 + kk) * N + n0 + (lane & 31)]; if (nw) v *= nw[k0 + kk]; scr[kk * 33 + (lane & 31)] = v; }
    asm volatile("s_waitcnt lgkmcnt(0)" ::: "memory");
    const int c = lane & 7; const int r0 = mode ? swmap(n0) : n0;
#pragma unroll
    for (int j = 0; j < 4; ++j) { const int n = (lane >> 3) + 8 * j; const LAS float* s = scr + (8 * c) * 33 + n;
        u32x4 o; o.x = pkbf(s[0 * 33], s[1 * 33]); o.y = pkbf(s[2 * 33], s[3 * 33]); o.z = pkbf(s[4 * 33], s[5 * 33]); o.w = pkbf(s[6 * 33], s[7 * 33]);
        *(u32x4*)(WT + (size_t)(r0 + n) * K + k0 + 8 * c) = o; }
    asm volatile("s_waitcnt lgkmcnt(0)" ::: "memory");
}
__device__ __forceinline__ void convert_weight(const float* W, int K, int N, bf16_t* WT, const float* nw, int mode, LAS float* scr, int gw, int ngw, int lane) {
    const int nitems = (K / 64) * (N / 32);
    for (int it = gw; it < nitems; it += ngw) transpose_item(W, K, N, WT, nw, mode, scr, it, lane);
}

namespace hg {
constexpr int C = 64, NCH = SEQ / C, NUNIT = BATCH * 8 * NCH;
constexpr int RS = 272, RT = 144;
constexpr int L_QD = 0, L_QI = 64 * RS, L_KI = 2 * 64 * RS, L_SP = 3 * 64 * RS, L_VT = L_SP + 128 * RS, L_AM = L_VT + 128 * RT, L_PART = L_AM + 64 * RT, L_END = L_PART + 2048;
constexpr int L1_KDT = 0, L1_VT = 128 * RT, L1_PART = 2 * 128 * RT;
static_assert(L_END <= 131072, "hgrn lds");

__device__ __forceinline__ void raw16(const unsigned short* P, int unit, int tid, unsigned short (&r)[16]) {
    const int b = unit >> 10, h = (unit >> 7) & 7, n = unit & 127, dk = tid & 127, cq = tid >> 7;
    const unsigned short* p = P + ((size_t)b * SEQ + (size_t)n * C + 16 * cq) * DM + h * 128 + dk;
#pragma unroll
    for (int i = 0; i < 16; ++i) r[i] = p[(size_t)i * DM];
}
__device__ __forceinline__ void bcum_of(const unsigned short (&raw)[16], int dk, int cq, LAS float* part, float (&lf)[16], float (&bc)[16], float& bmid, float& blast) {
#pragma unroll
    for (int i = 0; i < 16; ++i) lf[i] = -(float)raw[i] * (1.f / 32768.f);
    float run = 0.f;
#pragma unroll
    for (int i = 0; i < 16; ++i) { run += lf[i]; bc[i] = run; }
    part[cq * 128 + dk] = run;
    __syncthreads();
    const float p0 = part[dk], p1 = part[128 + dk], p2 = part[256 + dk], p3 = part[384 + dk];
    const float off = cq == 0 ? 0.f : (cq == 1 ? p0 : (cq == 2 ? p0 + p1 : p0 + p1 + p2));
    bmid = p0 + p1; blast = (p0 + p1) + (p2 + p3);
#pragma unroll
    for (int i = 0; i < 16; ++i) bc[i] += off;
}
__device__ __forceinline__ void stage_vt(const unsigned short (&v)[16], int dv, int cq, LAS unsigned char* vt) {
    u32x4 a, b;
    a.x = v[0] | ((unsigned)v[1] << 16); a.y = v[2] | ((unsigned)v[3] << 16); a.z = v[4] | ((unsigned)v[5] << 16); a.w = v[6] | ((unsigned)v[7] << 16);
    b.x = v[8] | ((unsigned)v[9] << 16); b.y = v[10] | ((unsigned)v[11] << 16); b.z = v[12] | ((unsigned)v[13] << 16); b.w = v[14] | ((unsigned)v[15] << 16);
    *(LAS u32x4*)(vt + dv * RT + cq * 32) = a; *(LAS u32x4*)(vt + dv * RT + cq * 32 + 16) = b;
}
__device__ __forceinline__ void h1_phase(LAS unsigned char* L, const unsigned short* LF, const bf16_t* VH, bf16_t* UT, float* DEC, int wave_s) {
    const int tid = fresh_tid(wave_s), lane = tid & 63, w = wave_s, dk = tid & 127, cq = tid >> 7, r32 = lane & 31, hi = lane >> 5;
    unsigned short rlf[16], rv[16];
    if ((int)blockIdx.x < NUNIT) { raw16(LF, blockIdx.x, tid, rlf); raw16(VH, blockIdx.x, tid, rv); }
    for (int unit = blockIdx.x; unit < NUNIT; unit += gridDim.x) {
        float lf[16], bc[16], bmid, blast;
        bcum_of(rlf, dk, cq, (LAS float*)(L + L1_PART), lf, bc, bmid, blast);
        unsigned pk[8];
#pragma unroll
        for (int i = 0; i < 16; i += 2) { const float k0 = (1.f - fexp(lf[i])) * fexp(blast - bc[i]), k1 = (1.f - fexp(lf[i + 1])) * fexp(blast - bc[i + 1]); pk[i >> 1] = pkbf(k0, k1); }
        *(LAS u32x4*)(L + L1_KDT + dk * RT + cq * 32) = (u32x4){pk[0], pk[1], pk[2], pk[3]};
        *(LAS u32x4*)(L + L1_KDT + dk * RT + cq * 32 + 16) = (u32x4){pk[4], pk[5], pk[6], pk[7]};
        stage_vt(rv, dk, cq, L + L1_VT);
        if (cq == 3) DEC[(size_t)unit * 128 + dk] = fexp(blast);
        __syncthreads();
        { const int nu = unit + (int)gridDim.x; if (nu < NUNIT) { raw16(LF, nu, tid, rlf); raw16(VH, nu, tid, rv); } }
        const int dvb = (w & 3) * 32, dkb = (w >> 2) * 64;
        f32x16 acc[2]; acc[0] = f32x16{}; acc[1] = f32x16{};
#pragma unroll
        for (int kk = 0; kk < 4; ++kk) {
            const bf16x8 a = *(const LAS bf16x8*)(L + L1_VT + (dvb + r32) * RT + (kk * 16 + 8 * hi) * 2);
#pragma unroll
            for (int t = 0; t < 2; ++t) { const bf16x8 bb = *(const LAS bf16x8*)(L + L1_KDT + (dkb + 32 * t + r32) * RT + (kk * 16 + 8 * hi) * 2);
                acc[t] = __builtin_amdgcn_mfma_f32_32x32x16_bf16(a, bb, acc[t], 0, 0, 0); }
        }
        bf16_t* up = UT + (size_t)unit * 16384;
#pragma unroll
        for (int t = 0; t < 2; ++t)
#pragma unroll
            for (int r = 0; r < 16; ++r) up[(dvb + crow(r, hi)) * 128 + dkb + 32 * t + r32] = f2bf(acc[t][r]);
        __syncthreads();
    }
}
__device__ __forceinline__ void scan_phase(bf16_t* UT, const float* DEC, int wave_s) {
    const int gt = blockIdx.x * NTHR + fresh_tid(wave_s), ngt = gridDim.x * NTHR;
    for (int g = gt; g < 32 * 4096; g += ngt) {
        const int bh = g >> 12, e = (g & 4095) * 4, dk = e & 127;
        float s0 = 0.f, s1 = 0.f, s2 = 0.f, s3 = 0.f;
        bf16_t* up = UT + (size_t)bh * 128 * 16384 + e; const float* dp = DEC + (size_t)bh * 128 * 128 + dk;
        for (int n0 = 0; n0 < NCH; n0 += 8) {
            u32x2 uu[8]; f32x4 dd[8];
#pragma unroll
            for (int j = 0; j < 8; ++j) { uu[j] = *(const u32x2*)(up + (size_t)(n0 + j) * 16384); dd[j] = *(const f32x4*)(dp + (size_t)(n0 + j) * 128); }
#pragma unroll
            for (int j = 0; j < 8; ++j) {
                u32x2 o; o.x = pkbf(s0, s1); o.y = pkbf(s2, s3);
                *(u32x2*)(up + (size_t)(n0 + j) * 16384) = o;
                s0 = dd[j][0] * s0 + __uint_as_float(uu[j].x << 16); s1 = dd[j][1] * s1 + __uint_as_float(uu[j].x & 0xffff0000u);
                s2 = dd[j][2] * s2 + __uint_as_float(uu[j].y << 16); s3 = dd[j][3] * s3 + __uint_as_float(uu[j].y & 0xffff0000u);
            }
        }
    }
}
__device__ __forceinline__ void h3_load_sp(const bf16_t* SP, int unit, int tid, u32x4 (&sp)[4]) {
    const bf16_t* p = SP + (size_t)unit * 16384;
#pragma unroll
    for (int j = 0; j < 4; ++j) { const int idx = tid + 512 * j; sp[j] = *(const u32x4*)(p + (idx >> 4) * 128 + (idx & 15) * 8); }
}
__device__ __forceinline__ void h3_phase(LAS unsigned char* L, bf16_t* QH, const unsigned short* LF, const bf16_t* VH, const bf16_t* GH, const bf16_t* SP, const float* gnw, int wave_s) {
    const int tid = fresh_tid(wave_s), lane = tid & 63, w = wave_s, dk = tid & 127, cq = tid >> 7, r32 = lane & 31, hi = lane >> 5;
    unsigned short rlf[16], rv[16], rq[16]; u32x4 rsp[4];
    if ((int)blockIdx.x < NUNIT) { raw16(LF, blockIdx.x, tid, rlf); raw16(VH, blockIdx.x, tid, rv); raw16(QH, blockIdx.x, tid, rq); h3_load_sp(SP, blockIdx.x, tid, rsp); }
    for (int unit = blockIdx.x; unit < NUNIT; unit += gridDim.x) {
        const int b = unit >> 10, h = (unit >> 7) & 7, n = unit & 127; const size_t row0 = (size_t)b * SEQ + (size_t)n * C;
#pragma unroll
        for (int j = 0; j < 4; ++j) { const int idx = tid + 512 * j; *(LAS u32x4*)(L + L_SP + (idx >> 4) * RS + (idx & 15) * 16) = rsp[j]; }
        stage_vt(rv, dk, cq, L + L_VT);
        {
            float lf[16], bc[16], bmid, blast;
            bcum_of(rlf, dk, cq, (LAS float*)(L + L_PART), lf, bc, bmid, blast);
#pragma unroll
            for (int i = 0; i < 16; ++i) {
                const float q = bf2f(rq[i]); const float k = 1.f - fexp(lf[i]);
                const int c = 16 * cq + i;
                *(LAS unsigned short*)(L + L_QD + c * RS + dk * 2) = f2bf(q * fexp(bc[i]));
                *(LAS unsigned short*)(L + L_QI + c * RS + dk * 2) = f2bf(q * fexp(bc[i] - bmid));
                *(LAS unsigned short*)(L + L_KI + c * RS + dk * 2) = f2bf(k * fexp(bmid - bc[i]));
            }
        }
        __syncthreads();
        { const int nu = unit + (int)gridDim.x; if (nu < NUNIT) { raw16(LF, nu, tid, rlf); raw16(VH, nu, tid, rv); raw16(QH, nu, tid, rq); h3_load_sp(SP, nu, tid, rsp); } }
        const int ec = tid >> 3, eseg = tid & 7; const size_t eoff = (row0 + ec) * DM + h * 128 + eseg * 16;
        const u32x4 g0 = *(const u32x4*)(GH + eoff), g1 = *(const u32x4*)(GH + eoff + 8);
        if (w < 4) {
            const int cb = (w & 1) * 32, cpb = (w >> 1) * 32;
            f32x16 a = f32x16{};
            if (!(cb == 0 && cpb == 32)) {
#pragma unroll
                for (int kk = 0; kk < 8; ++kk) {
                    const bf16x8 fa = *(const LAS bf16x8*)(L + L_QI + (cb + r32) * RS + (kk * 16 + 8 * hi) * 2);
                    const bf16x8 fb = *(const LAS bf16x8*)(L + L_KI + (cpb + r32) * RS + (kk * 16 + 8 * hi) * 2);
                    a = __builtin_amdgcn_mfma_f32_32x32x16_bf16(fa, fb, a, 0, 0, 0);
                }
            }
#pragma unroll
            for (int r = 0; r < 16; ++r) { const int c = cb + crow(r, hi), cp = cpb + r32; *(LAS unsigned short*)(L + L_AM + c * RT + cp * 2) = f2bf(cp <= c ? a[r] : 0.f); }
        }
        const int cb = (w & 1) * 32, dvb = (w >> 1) * 32;
        f32x16 o = f32x16{};
#pragma unroll
        for (int kk = 0; kk < 8; ++kk) {
            const bf16x8 fa = *(const LAS bf16x8*)(L + L_QD + (cb + r32) * RS + (kk * 16 + 8 * hi) * 2);
            const bf16x8 fb = *(const LAS bf16x8*)(L + L_SP + (dvb + r32) * RS + (kk * 16 + 8 * hi) * 2);
            o = __builtin_amdgcn_mfma_f32_32x32x16_bf16(fa, fb, o, 0, 0, 0);
        }
        __syncthreads();
#pragma unroll
        for (int kk = 0; kk < 4; ++kk) {
            const bf16x8 fa = *(const LAS bf16x8*)(L + L_AM + (cb + r32) * RT + (kk * 16 + 8 * hi) * 2);
            const bf16x8 fb = *(const LAS bf16x8*)(L + L_VT + (dvb + r32) * RT + (kk * 16 + 8 * hi) * 2);
            o = __builtin_amdgcn_mfma_f32_32x32x16_bf16(fa, fb, o, 0, 0, 0);
        }
        __syncthreads();
        LAS float* OF = (LAS float*)(L + L_QD);
#pragma unroll
        for (int r = 0; r < 16; ++r) OF[(cb + crow(r, hi)) * 132 + dvb + r32] = o[r];
        __syncthreads();
        {
            f32x4 v[4]; float ss = 0.f;
#pragma unroll
            for (int j = 0; j < 4; ++j) { v[j] = *(const LAS f32x4*)(OF + ec * 132 + eseg * 16 + 4 * j); ss += (v[j][0] * v[j][0] + v[j][1] * v[j][1]) + (v[j][2] * v[j][2] + v[j][3] * v[j][3]); }
            ss += __shfl_xor(ss, 1); ss += __shfl_xor(ss, 2); ss += __shfl_xor(ss, 4);
            const float rs = rsqrtf(ss * (1.f / 128.f) + EPS);
            const unsigned gg[8] = {g0.x, g0.y, g0.z, g0.w, g1.x, g1.y, g1.z, g1.w};
            unsigned ow[8];
#pragma unroll
            for (int j = 0; j < 4; ++j) {
                const f32x4 wv = *(const f32x4*)(gnw + eseg * 16 + 4 * j);
                const float a0 = v[j][0] * rs * wv[0] * __uint_as_float(gg[2 * j] << 16), a1 = v[j][1] * rs * wv[1] * __uint_as_float(gg[2 * j] & 0xffff0000u);
                const float a2 = v[j][2] * rs * wv[2] * __uint_as_float(gg[2 * j + 1] << 16), a3 = v[j][3] * rs * wv[3] * __uint_as_float(gg[2 * j + 1] & 0xffff0000u);
                ow[2 * j] = pkbf(a0, a1); ow[2 * j + 1] = pkbf(a2, a3);
            }
            *(u32x4*)(QH + eoff) = (u32x4){ow[0], ow[1], ow[2], ow[3]}; *(u32x4*)(QH + eoff + 8) = (u32x4){ow[4], ow[5], ow[6], ow[7]};
        }
        __syncthreads();
    }
}
}

__device__ __forceinline__ void x_prologue(const float* x, bf16_t* hb, float* ssq0, int gw, int ngw, int lane) {
    for (int m = gw; m < MTOK; m += ngw) {
        const f32x4* xr = (const f32x4*)(x + (size_t)m * DM) + lane; f32x4 v[4]; float s = 0.f;
#pragma unroll
        for (int j = 0; j < 4; ++j) { v[j] = xr[64 * j]; s += (v[j][0] * v[j][0] + v[j][1] * v[j][1]) + (v[j][2] * v[j][2] + v[j][3] * v[j][3]); }
        s = wave_sum(s);
        u32x2* o = (u32x2*)(hb + (size_t)m * DM) + lane;
#pragma unroll
        for (int j = 0; j < 4; ++j) { u32x2 w; w.x = pkbf(v[j][0], v[j][1]); w.y = pkbf(v[j][2], v[j][3]); o[64 * j] = w; }
        if (lane < 16) ssq0[(size_t)m * 16 + lane] = lane == 0 ? s : 0.f;
    }
}
__device__ __forceinline__ void combine_phase(const bf16_t* OB, bf16_t* AO, const float* subw, const float* lamp, int wave_s) {
    const float lam = __hip_atomic_load(lamp, __ATOMIC_RELAXED, __HIP_MEMORY_SCOPE_AGENT);
    const int gt = blockIdx.x * NTHR + fresh_tid(wave_s), ngt = gridDim.x * NTHR;
    const int sub = gt & 15;
    f32x4 w0 = *(const f32x4*)(subw + sub * 8), w1 = *(const f32x4*)(subw + sub * 8 + 4);
    for (int g = gt >> 4; g < MTOK * 8; g += ngt >> 4) {
        const int row = g >> 3, h = g & 7;
        const u32x4 a = *(const u32x4*)(OB + (size_t)row * 2048 + h * 128 + sub * 8), bq = *(const u32x4*)(OB + (size_t)row * 2048 + 1024 + h * 128 + sub * 8);
        const unsigned aa[4] = {a.x, a.y, a.z, a.w}, bb[4] = {bq.x, bq.y, bq.z, bq.w};
        float o[8]; float ss = 0.f;
#pragma unroll
        for (int j = 0; j < 4; ++j) { o[2 * j] = __uint_as_float(aa[j] << 16) - lam * __uint_as_float(bb[j] << 16); o[2 * j + 1] = __uint_as_float(aa[j] & 0xffff0000u) - lam * __uint_as_float(bb[j] & 0xffff0000u);
            ss += o[2 * j] * o[2 * j] + o[2 * j + 1] * o[2 * j + 1]; }
        ss += __shfl_xor(ss, 1); ss += __shfl_xor(ss, 2); ss += __shfl_xor(ss, 4); ss += __shfl_xor(ss, 8);
        const float rs = rsqrtf(ss * (1.f / 128.f) + EPS) * (1.f - LAMBDA_INIT);
        u32x4 wv; wv.x = pkbf(o[0] * rs * w0[0], o[1] * rs * w0[1]); wv.y = pkbf(o[2] * rs * w0[2], o[3] * rs * w0[3]); wv.z = pkbf(o[4] * rs * w1[0], o[5] * rs * w1[1]); wv.w = pkbf(o[6] * rs * w1[2], o[7] * rs * w1[3]);
        *(u32x4*)(AO + (size_t)row * DM + h * 128 + sub * 8) = wv;
    }
}
__device__ __forceinline__ void final_norm(const float* src, float* out, const float* fw, int gw, int ngw, int lane) {
    f32x4 wv[4];
#pragma unroll
    for (int j = 0; j < 4; ++j) wv[j] = *((const f32x4*)fw + lane + 64 * j);
    for (int m = gw; m < MTOK; m += ngw) {
        const f32x4* xr = (const f32x4*)(src + (size_t)m * DM) + lane; f32x4* orow = (f32x4*)(out + (size_t)m * DM) + lane; f32x4 v[4]; float s = 0.f;
#pragma unroll
        for (int j = 0; j < 4; ++j) { v[j] = xr[64 * j]; s += (v[j][0] * v[j][0] + v[j][1] * v[j][1]) + (v[j][2] * v[j][2] + v[j][3] * v[j][3]); }
        const float rs = rsqrtf(wave_sum(s) * (1.f / 1024.f) + EPS);
#pragma unroll
        for (int j = 0; j < 4; ++j) orow[64 * j] = v[j] * rs * wv[j];
    }
}
__device__ __forceinline__ int t5_bucket(int n) {
    if (n < 16) return n;
    const float nf = (float)n; int large = 16 + (int)(logf(nf / 16.f) / 2.0794415416798357f * 16.f);
    return large < 31 ? large : 31;
}

struct Args { const float* in[16]; float* out; unsigned char* ws; int ph_lo, ph_hi, coop, pad; };
constexpr int N_PHASES = 19;
#define PROBE_LO (-1)
#define PROBE_HI (-1)
#define PROBE_MULT 4

__global__ void __launch_bounds__(NTHR, 2) yoco_fwd(Args args) {
    extern __shared__ __attribute__((aligned(16))) unsigned char lds[];
    LAS unsigned char* L = (LAS unsigned char*)lds;
    const int wave = __builtin_amdgcn_readfirstlane(threadIdx.x >> 6);
    const int G = gridDim.x, gw = blockIdx.x * NWAVES + wave, ngw = G * NWAVES;
    unsigned char* ws = args.ws;
    const float* x = args.in[0]; const float* norm_w = args.in[1]; const float* ffn_w_in = args.in[2]; const float* ffn_w_out = args.in[3];
    float* ssq = (float*)(ws + WS_SSQ); float* lbv = (float*)(ws + WS_LB); float* btab = (float*)(ws + WS_BTAB); float* lamp = (float*)(ws + WS_LAM);
    bf16_t* HB = (bf16_t*)(ws + WS_HB); bf16_t* HID = (bf16_t*)(ws + WS_HID); float* OUT = args.out;
    const int lo = args.ph_lo, hi = args.ph_hi;
    cg::grid_group grid = cg::this_grid();
#define IN(k) (lo <= (k) && (k) < hi)
#define SEAM(k) do { if (args.coop && IN(k) && IN((k) + 1)) { asm volatile("s_waitcnt vmcnt(0) lgkmcnt(0)" ::: "memory"); grid.sync(); \
        if (wave == 0) asm volatile("s_waitcnt vmcnt(0)" ::: "memory"); __syncthreads(); } } while (0)
#define GEMM_PHASE(EPI, Aptr, Bptr, NN, KK, ...) do { pg8::Gemm g_{(const bf16_t*)(Aptr), (const bf16_t*)(Bptr), MTOK, (NN), (KK)}; pg8::StaticOrder S_; S_.init(MTOK, (NN), G, (int)blockIdx.x); \
        EPI E_{__VA_ARGS__}; pg8::gemm_phase<EPI, pg8::StaticOrder, true, true>(L, g_, S_, E_, wave); } while (0)
    LAS float* scr = (LAS float*)(L + wave * 16384);
    typedef epi::EpiRes<true, false> EpiRes0; typedef epi::EpiRes<false, false> EpiResM; typedef epi::EpiRes<false, true> EpiResL;
    unsigned char* LO = (unsigned char*)args.out;
    float* HF = (float*)(ws + WS_KV);

    unsigned long long pt_s = 0, pt_acc = 0;
#define PB(k) do { if ((k) == PROBE_LO) pt_s = __builtin_amdgcn_s_memrealtime(); } while (0)
#define PE(k) do { if ((k) == PROBE_HI) pt_acc = __builtin_amdgcn_s_memrealtime() - pt_s; } while (0)
    PB(0);
    if (IN(0)) {
        const int tid = fresh_tid(wave), lane = tid & 63;
        convert_weight(ffn_w_in, 1024, NFF, (bf16_t*)(ws + WS_FI00), norm_w + 0 * 1024, 1, scr, gw, ngw, lane);
        convert_weight(ffn_w_in + (size_t)1 * 1024 * NFF, 1024, NFF, (bf16_t*)(ws + WS_FI01), norm_w + 2 * 1024, 1, scr, gw, ngw, lane);
        convert_weight(ffn_w_out, DFF, 1024, (bf16_t*)(ws + WS_FO00), nullptr, 0, scr, gw, ngw, lane);
        convert_weight(ffn_w_out + (size_t)1 * DFF * 1024, DFF, 1024, (bf16_t*)(ws + WS_FO01), nullptr, 0, scr, gw, ngw, lane);
        convert_weight(args.in[4], 1024, 4096, (bf16_t*)(ws + WS_HIN), norm_w + 1 * 1024, 0, scr, gw, ngw, lane);
        convert_weight(args.in[7], 1024, 1024, (bf16_t*)(ws + WS_HOUT), nullptr, 0, scr, gw, ngw, lane);
        x_prologue(x, HB, ssq, gw, ngw, lane);
        if (blockIdx.x == 0) {
            const float* hlb = args.in[5];
            for (int i = tid; i < 1024; i += NTHR) { const float a0 = hlb[i], a1 = hlb[1024 + i]; lbv[i] = 1.f / (1.f + expf(a1 - a0)); }
            const float* rb = args.in[10];
            for (int i = tid; i < 1024; i += NTHR) { const int h = i >> 7, d = i & 127; btab[i] = (rb[t5_bucket(d) * 8 + h] - rb[31 * 8 + h]) * LOG2E; }
            if (wave == 0) { const float* lp = args.in[12]; const float a = wave_sum(lp[lane] * lp[64 + lane]), b2 = wave_sum(lp[128 + lane] * lp[192 + lane]);
                if (lane == 0) *lamp = expf(a) - expf(b2) + LAMBDA_INIT; }
        }
    }
    SEAM(0); PE(0); PB(1);
    if (IN(1)) GEMM_PHASE(epi::EpiSwiglu, HB, ws + WS_FI00, NFF, 1024, HID, ssq + (size_t)0 * MTOK * 16);
    SEAM(1); PE(1); PB(2);
    if (IN(2)) GEMM_PHASE(EpiRes0, HID, ws + WS_FO00, 1024, DFF, x, HB, LO, nullptr, ssq + (size_t)1 * MTOK * 16, 0.5f);
    SEAM(2); PE(2); PB(3);
    if (IN(3)) GEMM_PHASE(epi::EpiHgrnIn, HB, ws + WS_HIN, 4096, 1024, (bf16_t*)(ws + WS_QH), (unsigned short*)(ws + WS_LF), (bf16_t*)(ws + WS_VH), (bf16_t*)(ws + WS_GH), ssq + (size_t)1 * MTOK * 16, lbv);
    SEAM(3); PE(3); PB(4);
    if (IN(4)) hg::h1_phase(L, (const unsigned short*)(ws + WS_LF), (const bf16_t*)(ws + WS_VH), (bf16_t*)(ws + WS_UT), (float*)(ws + WS_DEC), wave);
    SEAM(4); PE(4); PB(5);
    if (IN(5)) hg::scan_phase((bf16_t*)(ws + WS_UT), (const float*)(ws + WS_DEC), wave);
    SEAM(5); PE(5); PB(6);
    if (IN(6)) hg::h3_phase(L, (bf16_t*)(ws + WS_QH), (const unsigned short*)(ws + WS_LF), (const bf16_t*)(ws + WS_VH), (const bf16_t*)(ws + WS_GH), (const bf16_t*)(ws + WS_UT), args.in[6], wave);
    SEAM(6); PE(6); PB(7);
    if (IN(7)) GEMM_PHASE(EpiResM, ws + WS_QH, ws + WS_HOUT, 1024, 1024, nullptr, HB, LO, nullptr, ssq + (size_t)2 * MTOK * 16, 1.0f);
    SEAM(7); PE(7); PB(8);
    if (IN(8)) {
        GEMM_PHASE(epi::EpiSwiglu, HB, ws + WS_FI01, NFF, 1024, HID, ssq + (size_t)2 * MTOK * 16);
        const int lane = fresh_tid(wave) & 63;
        convert_weight(ffn_w_in + (size_t)2 * 1024 * NFF, 1024, NFF, (bf16_t*)(ws + WS_FI10), norm_w + 3 * 1024, 1, scr, gw, ngw, lane);
        convert_weight(ffn_w_in + (size_t)3 * 1024 * NFF, 1024, NFF, (bf16_t*)(ws + WS_FI11), norm_w + 5 * 1024, 1, scr, gw, ngw, lane);
        convert_weight(ffn_w_out + (size_t)2 * DFF * 1024, DFF, 1024, (bf16_t*)(ws + WS_FO10), nullptr, 0, scr, gw, ngw, lane);
        convert_weight(ffn_w_out + (size_t)3 * DFF * 1024, DFF, 1024, (bf16_t*)(ws + WS_FO11), nullptr, 0, scr, gw, ngw, lane);
        convert_weight(args.in[9], 1024, 2048, (bf16_t*)(ws + WS_WKV), args.in[8], 0, scr, gw, ngw, lane);
        convert_weight(args.in[11], 1024, 1024, (bf16_t*)(ws + WS_WQ), norm_w + 4 * 1024, 0, scr, gw, ngw, lane);
        convert_weight(args.in[14], 1024, 1024, (bf16_t*)(ws + WS_WAO), nullptr, 0, scr, gw, ngw, lane);
    }
    SEAM(8); PE(8); PB(9);
    if (IN(9)) GEMM_PHASE(EpiResM, HID, ws + WS_FO01, 1024, DFF, nullptr, HB, LO, nullptr, ssq + (size_t)3 * MTOK * 16, 0.5f);
    SEAM(9); PE(9); PB(10);
    if (IN(10)) {
        GEMM_PHASE(epi::EpiKV, HB, ws + WS_WKV, 2048, 1024, (bf16_t*)(ws + WS_KV), (bf16_t*)(ws + WS_KV + 64 * MiB), ssq + (size_t)3 * MTOK * 16);
        GEMM_PHASE(epi::EpiSwiglu, HB, ws + WS_FI10, NFF, 1024, HID, ssq + (size_t)3 * MTOK * 16);
    }
    SEAM(10); PE(10); PB(11);
    if (IN(11)) GEMM_PHASE(EpiResM, HID, ws + WS_FO10, 1024, DFF, nullptr, HB, LO, nullptr, ssq + (size_t)4 * MTOK * 16, 0.5f);
    SEAM(11); PE(11); PB(12);
    if (IN(12)) GEMM_PHASE(epi::EpiBf16, HB, ws + WS_WQ, 1024, 1024, (bf16_t*)(ws + WS_QB), 1024, ssq + (size_t)4 * MTOK * 16, QSCALE);
    SEAM(12); PE(12); PB(13);
    if (IN(13)) {
        const attn_body::AttnTensors AT{(const attn_body::bf16*)(ws + WS_QB), (const attn_body::bf16*)(ws + WS_KV), (const attn_body::bf16*)(ws + WS_KV + 64 * MiB), (attn_body::bf16*)(ws + WS_OB), btab};
        const attn_body::StaticOrder S((int)G, (int)blockIdx.x);
        attn_body::attn_phase<attn_body::StaticOrder>((char*)lds, AT, S, wave);
    }
    SEAM(13); PE(13); PB(14);
    if (IN(14)) combine_phase((const bf16_t*)(ws + WS_OB), (bf16_t*)(ws + WS_QB), args.in[13], lamp, wave);
    SEAM(14); PE(14); PB(15);
    if (IN(15)) GEMM_PHASE(EpiResM, ws + WS_QB, ws + WS_WAO, 1024, 1024, nullptr, HB, LO, nullptr, ssq + (size_t)5 * MTOK * 16, 1.0f);
    SEAM(15); PE(15); PB(16);
    if (IN(16)) GEMM_PHASE(epi::EpiSwiglu, HB, ws + WS_FI11, NFF, 1024, HID, ssq + (size_t)5 * MTOK * 16);
    SEAM(16); PE(16); PB(17);
    if (IN(17)) GEMM_PHASE(EpiResL, HID, ws + WS_FO11, 1024, DFF, nullptr, HB, LO, HF, ssq + (size_t)6 * MTOK * 16, 0.5f);
    SEAM(17); PE(17); PB(18);
    if (IN(18)) final_norm(HF, OUT, args.in[15], gw, ngw, fresh_tid(wave) & 63);
    PE(18);
    if (PROBE_LO >= 0) { const unsigned long long t0_ = __builtin_amdgcn_s_memrealtime(); while (__builtin_amdgcn_s_memrealtime() - t0_ < PROBE_MULT * pt_acc) __builtin_amdgcn_s_sleep(8); }
#undef IN
#undef SEAM
#undef GEMM_PHASE
}

#ifndef MK_COOP
#define MK_COOP 1
#endif
extern "C" void kernel_launch(void* const* d_in, const int* in_sizes, int n_in, void* d_out, int out_size, void* d_ws, size_t ws_size, hipStream_t stream) {
    static int grid = 0;
    if (grid == 0) {
        if (n_in != 16 || in_sizes[0] != MTOK * DM || out_size != MTOK * DM || ws_size < WS_END) { fprintf(stderr, "kernel_launch: unexpected shapes (n_in %d, in0 %d, out %d, ws %zu)\n", n_in, n_in > 0 ? in_sizes[0] : -1, out_size, ws_size); grid = -1; return; }
        int dev = 0, cus = 0, per_cu = 0;
        hipGetDevice(&dev); hipDeviceGetAttribute(&cus, hipDeviceAttributeMultiprocessorCount, dev);
        hipFuncSetAttribute((const void*)yoco_fwd, hipFuncAttributeMaxDynamicSharedMemorySize, LDS_BYTES);
        hipOccupancyMaxActiveBlocksPerMultiprocessor(&per_cu, (const void*)yoco_fwd, NTHR, LDS_BYTES);
        if (per_cu < 1) { fprintf(stderr, "kernel_launch: occupancy query says %d blocks per CU\n", per_cu); per_cu = 1; }
        (void)hipGetLastError();
        grid = cus;
        if (grid > 256) grid = 256;
        grid &= ~7;
    }
    if (grid <= 0) return;
    Args a{};
    for (int i = 0; i < 16; ++i) a.in[i] = (const float*)d_in[i];
    a.out = (float*)d_out; a.ws = (unsigned char*)d_ws;
#if MK_COOP
    a.ph_lo = 0; a.ph_hi = N_PHASES; a.coop = 1;
    void* kargs[] = {&a};
    hipError_t e = hipLaunchCooperativeKernel((const void*)yoco_fwd, dim3(grid), dim3(NTHR), kargs, LDS_BYTES, stream);
    if (e != hipSuccess) fprintf(stderr, "cooperative launch failed: %s (grid %d)\n", hipGetErrorString(e), grid);
#else
    for (int p = 0; p < N_PHASES; ++p) { a.ph_lo = p; a.ph_hi = p + 1; a.coop = 0; hipLaunchKernelGGL(yoco_fwd, dim3(grid), dim3(NTHR), LDS_BYTES, stream, a); }
#endif
}
```

```cpp
#include <hip/hip_runtime.h>
#include <hip/hip_bf16.h>
#include <hip/hip_cooperative_groups.h>
#include <cstdio>
#include <cstdint>
#include <cmath>
namespace cg = cooperative_groups;
__device__ __forceinline__ int fresh_tid(int wave_s) { int l; asm volatile("v_mbcnt_lo_u32_b32 %0, -1, 0\n\tv_mbcnt_hi_u32_b32 %0, -1, %0" : "=v"(l)); return wave_s * 64 + l; }
namespace pg8 {
#define PG8_LAS __attribute__((address_space(3)))
typedef unsigned short bf16_t;
typedef short bf16x8 __attribute__((ext_vector_type(8)));
typedef float f32x4 __attribute__((ext_vector_type(4)));
typedef unsigned u32x4 __attribute__((ext_vector_type(4)));
constexpr int BM = 256, BK = 64, HALF = 128, HTB = HALF * BK * 2  , STAGE_BYTES = 8 * HTB, NXCD = 8, WGM = 8;

__host__ __device__ __forceinline__ int lds_byte(int r, int c) { const int st = (r >> 4) * 2 + (c >> 5), rr = r & 15, cc = c & 31, ob = rr * 64 + cc * 2; return st * 1024 + (ob ^ (((ob >> 9) & 1) << 5)); }
__host__ __device__ __forceinline__ void stage_rc(int b, int& R, int& C) { const int st = b / 1024, sb = b % 1024, swz = sb ^ (((sb >> 9) & 1) << 5); R = (st >> 1) * 16 + swz / 64; C = (st & 1) * 32 + (swz % 64) / 2; }
__host__ __device__ __forceinline__ int perm32(int rho) { const int n = rho >> 4, i = rho & 15; return 8 * (i >> 2) + 4 * n + (i & 3); }

struct Unit { int pm, pn; };
struct Gemm { const bf16_t* A; const bf16_t* Bt; int M, N, K; };

struct StaticOrder {
    int nM, nN, nwg, G, c;
    __host__ __device__ void init(int M, int N, int G_, int c_) { nM = M / BM; nN = N / BM; nwg = nM * nN; G = G_; c = c_; }
    __host__ __device__ bool next(int i, Unit& u) const {
        const long L = (long)i * G + c; if (L >= nwg) return false;
        int wgid = (int)L; { const int q = nwg / NXCD, r = nwg % NXCD, xcd = wgid % NXCD, off = wgid / NXCD; wgid = (xcd < r ? xcd * (q + 1) : r * (q + 1) + (xcd - r) * q) + off; }
        const int nig = WGM * nN, gid = wgid / nig, fm = gid * WGM, gsz = (nM - fm) < WGM ? (nM - fm) : WGM;
        u.pm = fm + ((wgid % nig) % gsz); u.pn = (wgid % nig) / gsz; return true;
    }
    __device__ __forceinline__ void a_ready(const Unit&) const {}
    __device__ __forceinline__ void done(const Unit&) const {}
};

__device__ __forceinline__ unsigned cvt_pk_bf16(float lo, float hi) { unsigned r; asm volatile("v_cvt_pk_bf16_f32 %0, %1, %2" : "=v"(r) : "v"(lo), "v"(hi)); return r; }
typedef float f32x2 __attribute__((ext_vector_type(2)));
template <class Epi, class Sched, bool ALIGN_EPI = false, bool SP2 = false>
__device__ __forceinline__ void gemm_phase(PG8_LAS unsigned char* lds, const Gemm g, const Sched& S, const Epi& E, int wave_s) {
    const int tid = fresh_tid(wave_s), wid = wave_s, lane = tid & 63, wr = wid >> 2, wc = wid & 3, fr = lane & 15, fq = lane >> 4;
    const int K = g.K, nt = K / BK;
    unsigned voffA[2], voffB[2];
#pragma unroll
    for (int i = 0; i < 2; ++i) { int R, C; stage_rc(tid * 16 + i * 8192, R, C); const int Rb = Epi::PERM ? ((R & ~31) + perm32(R & 31)) : R;
        voffA[i] = (unsigned)(R * K + C) * 2u; voffB[i] = (unsigned)(Rb * K + C) * 2u; }
    const size_t kstep = (size_t)(BK * 2);
    const size_t hstep = (size_t)HALF * K * 2;
    const size_t tstep = 2 * hstep;
    const unsigned ldsw = (unsigned)wid * 1024u;
    const int aoff = lds_byte(wr * 64 + fr, fq * 8), boff = lds_byte(wc * 32 + fr, fq * 8);
#define PG8_SA(b, h) (((b) * 2 + (h)) * HTB)
#define PG8_SB(b, h) ((4 + (b) * 2 + (h)) * HTB)
#define PG8_STAGE(bufoff, gbase, voff) do { _Pragma("unroll") for (int _i = 0; _i < 2; ++_i) \
        __builtin_amdgcn_global_load_lds((const unsigned*)((const char*)(gbase) + (voff)[_i]), (PG8_LAS unsigned*)(lds + (bufoff) + ldsw + _i * 8192), 16, 0, 0); } while (0)
#define PG8_LDA(dst, b, h) do { _Pragma("unroll") for (int m = 0; m < 4; ++m) _Pragma("unroll") for (int k = 0; k < 2; ++k) dst[m][k] = *(const PG8_LAS bf16x8*)(lds + PG8_SA(b, h) + aoff + m * 2048 + k * 1024); } while (0)
#define PG8_LDB(dst, b, h) do { _Pragma("unroll") for (int n = 0; n < 2; ++n) _Pragma("unroll") for (int k = 0; k < 2; ++k) dst[n][k] = *(const PG8_LAS bf16x8*)(lds + PG8_SB(b, h) + boff + n * 2048 + k * 1024); } while (0)
#define PG8_MMA(ai, bj, At, Bt) do { __builtin_amdgcn_s_setprio(1); _Pragma("unroll") for (int m = 0; m < 4; ++m) _Pragma("unroll") for (int n = 0; n < 2; ++n) _Pragma("unroll") for (int k = 0; k < 2; ++k) \
        acc[ai][bj][m][n] = __builtin_amdgcn_mfma_f32_16x16x32_bf16(Bt[n][k], At[m][k], acc[ai][bj][m][n], 0, 0, 0); __builtin_amdgcn_s_setprio(0); } while (0)
#define PG8_WAIT_V(n) asm volatile("s_waitcnt vmcnt(" #n ")" ::: "memory")
#define PG8_WAIT_L(n) asm volatile("s_waitcnt lgkmcnt(" #n ")" ::: "memory")
#define PG8_BAR __builtin_amdgcn_s_barrier()
#define PG8_DMA_FENCE do { const unsigned f_ = *(volatile PG8_LAS unsigned*)(lds + ldsw); asm volatile("s_waitcnt lgkmcnt(0)" :: "v"(f_) : "memory"); } while (0)
#define PG8_SCHED __builtin_amdgcn_sched_barrier(0)
    Unit cur, nxt; int ui = 0;
    if (!S.next(0, cur)) return;
    f32x4 acc[2][2][4][2];
#pragma unroll
    for (int a = 0; a < 2; ++a)
#pragma unroll
        for (int b = 0; b < 2; ++b)
#pragma unroll
            for (int m = 0; m < 4; ++m)
#pragma unroll
                for (int n = 0; n < 2; ++n) acc[a][b][m][n] = (f32x4){0.f, 0.f, 0.f, 0.f};
    bf16x8 At[4][2], B0[2][2], B1[2][2];
    const char* cA = (const char*)g.A + (size_t)cur.pm * tstep; const char* cB = (const char*)g.Bt + (size_t)cur.pn * tstep;
    S.a_ready(cur);
    if constexpr (SP2) {
        PG8_STAGE(PG8_SB(0, 0), cB, voffB); PG8_STAGE(PG8_SB(0, 1), cB + hstep, voffB); PG8_STAGE(PG8_SA(0, 0), cA, voffA); PG8_STAGE(PG8_SA(0, 1), cA + hstep, voffA);
        if (wr == 1) PG8_BAR;
        PG8_WAIT_V(2); PG8_DMA_FENCE; PG8_BAR;
        PG8_STAGE(PG8_SB(1, 0), cB + kstep, voffB); PG8_STAGE(PG8_SA(1, 0), cA + kstep, voffA); PG8_STAGE(PG8_SB(1, 1), cB + hstep + kstep, voffB);
        PG8_WAIT_V(6); PG8_DMA_FENCE; PG8_BAR;
    } else {
        PG8_STAGE(PG8_SB(0, 0), cB, voffB); PG8_STAGE(PG8_SA(0, 0), cA, voffA); PG8_STAGE(PG8_SB(0, 1), cB + hstep, voffB); PG8_STAGE(PG8_SA(0, 1), cA + hstep, voffA);
        if (wr == 1) PG8_BAR;
        PG8_WAIT_V(4); PG8_BAR;
        PG8_STAGE(PG8_SB(1, 0), cB + kstep, voffB); PG8_STAGE(PG8_SA(1, 0), cA + kstep, voffA); PG8_STAGE(PG8_SB(1, 1), cB + hstep + kstep, voffB);
        PG8_WAIT_V(6); PG8_BAR;
    }
    for (;;) {
        const bool has_next = S.next(ui + 1, nxt);
        const char* nA = has_next ? (const char*)g.A + (size_t)nxt.pm * tstep : cA; const char* nB = has_next ? (const char*)g.Bt + (size_t)nxt.pn * tstep : cB;
        for (int t = 0; t < nt; t += 2) {
            const bool last = (t == nt - 2);
            const char* a1 = cA + (size_t)(t + 1) * kstep;
            const char* a2 = last ? nA : cA + (size_t)(t + 2) * kstep; const char* b2 = last ? nB : cB + (size_t)(t + 2) * kstep;
            const char* a3 = a2 + kstep; const char* b3 = b2 + kstep;
            if (last && has_next) S.a_ready(nxt);
            if constexpr (SP2) {
            PG8_LDB(B0, 0, 0); PG8_LDB(B1, 0, 1); PG8_SCHED; PG8_LDA(At, 0, 0); PG8_STAGE(PG8_SA(1, 1), a1 + hstep, voffA);
            PG8_WAIT_V(8); PG8_WAIT_L(0); PG8_BAR; PG8_MMA(0, 0, At, B0); PG8_MMA(0, 1, At, B1); PG8_BAR; PG8_SCHED;
            PG8_LDA(At, 0, 1); PG8_STAGE(PG8_SB(0, 0), b2, voffB); PG8_STAGE(PG8_SB(0, 1), b2 + hstep, voffB); PG8_STAGE(PG8_SA(0, 0), a2, voffA);
            PG8_WAIT_V(8); PG8_WAIT_L(0); PG8_BAR; PG8_MMA(1, 0, At, B0); PG8_MMA(1, 1, At, B1); PG8_BAR; PG8_SCHED;
            PG8_LDB(B0, 1, 0); PG8_LDB(B1, 1, 1); PG8_SCHED; PG8_LDA(At, 1, 0); PG8_STAGE(PG8_SA(0, 1), a2 + hstep, voffA);
            PG8_WAIT_V(8); PG8_WAIT_L(0); PG8_BAR; PG8_MMA(0, 0, At, B0); PG8_MMA(0, 1, At, B1); PG8_BAR; PG8_SCHED;
            PG8_LDA(At, 1, 1); PG8_STAGE(PG8_SB(1, 0), b3, voffB); PG8_STAGE(PG8_SB(1, 1), b3 + hstep, voffB); PG8_STAGE(PG8_SA(1, 0), a3, voffA);
            PG8_WAIT_V(8); PG8_WAIT_L(0); PG8_BAR; PG8_MMA(1, 0, At, B0); PG8_MMA(1, 1, At, B1); PG8_BAR; PG8_SCHED;
            } else {
            PG8_LDB(B0, 0, 0); PG8_SCHED; PG8_LDA(At, 0, 0); PG8_STAGE(PG8_SA(1, 1), a1 + hstep, voffA);
            PG8_WAIT_L(8); PG8_BAR; PG8_WAIT_L(0); PG8_MMA(0, 0, At, B0); PG8_BAR; PG8_SCHED;
            PG8_LDB(B1, 0, 1); PG8_STAGE(PG8_SB(0, 0), b2, voffB);
            PG8_BAR; PG8_WAIT_L(0); PG8_MMA(0, 1, At, B1); PG8_BAR;
            PG8_LDA(At, 0, 1); PG8_STAGE(PG8_SA(0, 0), a2, voffA);
            PG8_BAR; PG8_WAIT_L(0); PG8_MMA(1, 0, At, B0); PG8_BAR; PG8_SCHED;
            PG8_STAGE(PG8_SB(0, 1), b2 + hstep, voffB);
            PG8_WAIT_V(6); PG8_BAR; PG8_MMA(1, 1, At, B1); PG8_BAR;
            PG8_LDB(B0, 1, 0); PG8_SCHED; PG8_LDA(At, 1, 0); PG8_STAGE(PG8_SA(0, 1), a2 + hstep, voffA);
            PG8_WAIT_L(8); PG8_BAR; PG8_WAIT_L(0); PG8_MMA(0, 0, At, B0); PG8_BAR; PG8_SCHED;
            PG8_LDB(B1, 1, 1); PG8_STAGE(PG8_SB(1, 0), b3, voffB);
            PG8_BAR; PG8_WAIT_L(0); PG8_MMA(0, 1, At, B1); PG8_BAR;
            PG8_LDA(At, 1, 1); PG8_STAGE(PG8_SA(1, 0), a3, voffA);
            PG8_BAR; PG8_WAIT_L(0); PG8_MMA(1, 0, At, B0); PG8_BAR; PG8_SCHED;
            PG8_STAGE(PG8_SB(1, 1), b3 + hstep, voffB);
            PG8_WAIT_V(6); PG8_BAR; PG8_MMA(1, 1, At, B1); PG8_BAR;
            }
        }
        if constexpr (ALIGN_EPI) { if (wr == 0) PG8_BAR; }
        if constexpr (!Epi::AFTER_DRAIN) { E(acc, cur, wr, wc, fr, fq); S.done(cur); }
        if (!has_next) break;
#pragma unroll
        for (int a = 0; a < 2; ++a)
#pragma unroll
            for (int b = 0; b < 2; ++b)
#pragma unroll
                for (int m = 0; m < 4; ++m)
#pragma unroll
                    for (int n = 0; n < 2; ++n) acc[a][b][m][n] = (f32x4){0.f, 0.f, 0.f, 0.f};
        cur = nxt; cA = nA; cB = nB; ++ui;
        if constexpr (ALIGN_EPI) { if (wr == 1) PG8_BAR; }
    }
    PG8_WAIT_V(0);
    if constexpr (!ALIGN_EPI) { if (wr == 0) PG8_BAR; }
    PG8_BAR;
    if constexpr (Epi::AFTER_DRAIN) { E.fused(acc, cur, wr, wc, fr, fq, lds, wid, lane); S.done(cur); }
#undef PG8_SA
#undef PG8_SB
#undef PG8_STAGE
#undef PG8_LDA
#undef PG8_LDB
#undef PG8_MMA
#undef PG8_WAIT_V
#undef PG8_WAIT_L
#undef PG8_BAR
#undef PG8_DMA_FENCE
#undef PG8_SCHED
}
}
#include <hip/hip_bf16.h>
namespace attn_body {
using bf16=__hip_bfloat16;
using bf16x8=__attribute__((ext_vector_type(8)))short;
using s16x4=__attribute__((ext_vector_type(4)))short;
using f32x16=__attribute__((ext_vector_type(16)))float;
using u32x4=__attribute__((ext_vector_type(4)))unsigned;
constexpr int BATCH=4,NHEAD=32,SEQ=8192,D=64,QP=1024,KP=64,VP=64,OP=2048;
constexpr int NW=8,QBLK=32,QB=QBLK*NW,KVBLK=64,NQB=SEQ/QB;
constexpr int ATTN_UNIT_ROWS=QB;
__device__ __forceinline__ int crow(int r,int hi){return (r&3)+8*(r>>2)+4*hi;}
#define SBAR() __builtin_amdgcn_sched_barrier(0)
__device__ __forceinline__ void cmask(f32x16&p0,f32x16&p1,int jb,int qrel,int hi){
  const float NEG=-INFINITY; int kb=64*jb+4*hi;
  #pragma unroll
  for(int r=0;r<16;++r){int kv=kb+(r&3)+8*(r>>2); if(kv>qrel)p0[r]=NEG; if(kv+32>qrel)p1[r]=NEG;}
}

__device__ __forceinline__ void addbias(f32x16&p0,f32x16&p1,const __attribute__((address_space(3))) float* tb){
  #pragma unroll
  for(int r=0;r<16;++r){ p0[r]+=tb[-((r&3)+8*(r>>2))]; p1[r]+=tb[-((r&3)+8*(r>>2))-32]; }
}
constexpr int NSLOT=3, SLOTB=8192;
constexpr int LDS_K=0, LDS_V=NSLOT*SLOTB, LDS_WS=2*NSLOT*SLOTB, LDS_OST=LDS_WS+NW*64*4, LDS_BYTES=LDS_OST+NW*4096;
constexpr float C2=0.125f*1.4426950408889634f;
__device__ __forceinline__ void glds16(const void*gsrc,unsigned lds_dst){unsigned keep;
  asm volatile("s_mov_b32 %0, m0\n\ts_mov_b32 m0, %2\n\ts_nop 0\n\tglobal_load_lds_dwordx4 %1, off\n\ts_mov_b32 m0, %0":"=&s"(keep):"v"(gsrc),"s"(lds_dst):"memory");}
__device__ __forceinline__ float max3f(float a,float b,float c){float r;asm("v_max3_f32 %0, %1, %2, %3":"=v"(r):"v"(a),"v"(b),"v"(c));return r;}
__device__ __forceinline__ float max2f(float a,float b){float r;asm("v_max_f32_e32 %0, %1, %2":"=v"(r):"v"(a),"v"(b));return r;}
__device__ __forceinline__ float fadd_s(float a,float b){float r;asm("v_add_f32_e32 %0, %1, %2":"=v"(r):"v"(a),"v"(b));return r;}
__device__ __forceinline__ float fsub_s(float a,float b){float r;asm("v_sub_f32_e32 %0, %1, %2":"=v"(r):"v"(a),"v"(b));return r;}
typedef float f32x2_t __attribute__((ext_vector_type(2))); typedef __bf16 bf16x2_t __attribute__((ext_vector_type(2)));
__device__ __forceinline__ unsigned cvtpk_s(float lo,float hi){f32x2_t v={lo,hi};bf16x2_t b=__builtin_convertvector(v,bf16x2_t);return __builtin_bit_cast(unsigned,b);}
#define WAIT_BAR(N) asm volatile("s_waitcnt vmcnt(" #N ") lgkmcnt(0)\n\tds_read_b32 %0, %1\n\ts_waitcnt lgkmcnt(0)\n\ts_nop 15\n\ts_barrier":"=&v"(fence_tmp):"v"(kdst):"memory")

__device__ __forceinline__ void qkt(f32x16&p0,f32x16&p1,const char*Kslot,const bf16x8*qr,const f32x16&negm,int r32,int hi){
  const char*kb=Kslot+hi*1024+r32*16;
  #pragma unroll
  for(int d0=0;d0<4;++d0){
    const bf16x8 b0=*reinterpret_cast<const bf16x8*>(kb+d0*2048);
    const bf16x8 b1=*reinterpret_cast<const bf16x8*>(kb+d0*2048+512);
    if(d0==0){p0=__builtin_amdgcn_mfma_f32_32x32x16_bf16(b0,qr[0],negm,0,0,0);p1=__builtin_amdgcn_mfma_f32_32x32x16_bf16(b1,qr[0],negm,0,0,0);}
    else{p0=__builtin_amdgcn_mfma_f32_32x32x16_bf16(b0,qr[d0],p0,0,0,0);p1=__builtin_amdgcn_mfma_f32_32x32x16_bf16(b1,qr[d0],p1,0,0,0);}}
}
typedef __attribute__((address_space(3))) const char* lds_cptr;
typedef short v4i16_t __attribute__((ext_vector_type(4)));
__device__ __forceinline__ void kload8(bf16x8*kf,lds_cptr kp){
  kf[0]=*(const __attribute__((address_space(3))) bf16x8*)(kp);      kf[1]=*(const __attribute__((address_space(3))) bf16x8*)(kp+512);
  kf[2]=*(const __attribute__((address_space(3))) bf16x8*)(kp+2048); kf[3]=*(const __attribute__((address_space(3))) bf16x8*)(kp+2560);
  kf[4]=*(const __attribute__((address_space(3))) bf16x8*)(kp+4096); kf[5]=*(const __attribute__((address_space(3))) bf16x8*)(kp+4608);
  kf[6]=*(const __attribute__((address_space(3))) bf16x8*)(kp+6144); kf[7]=*(const __attribute__((address_space(3))) bf16x8*)(kp+6656);
}
__device__ __forceinline__ void kload2(bf16x8*kf,lds_cptr kp,int j){ kf[2*j]=*(const __attribute__((address_space(3))) bf16x8*)(kp+j*2048); kf[2*j+1]=*(const __attribute__((address_space(3))) bf16x8*)(kp+j*2048+512); }
__device__ __forceinline__ s16x4 vtr(lds_cptr p){ return __builtin_bit_cast(s16x4,__builtin_amdgcn_ds_read_tr16_b64_v4i16((__attribute__((address_space(3))) v4i16_t*)p)); }
__device__ __forceinline__ float rowmax(const f32x16&p0,const f32x16&p1){
  float a=max3f(p0[0],p0[1],p1[0]),b=max3f(p0[2],p0[3],p1[1]);a=max3f(a,p1[2],p1[3]);
  #pragma unroll
  for(int r=4;r<16;r+=4){a=max3f(a,p0[r],p0[r+1]);b=max3f(b,p0[r+2],p0[r+3]);a=max3f(a,p1[r],p1[r+1]);b=max3f(b,p1[r+2],p1[r+3]);}
  const float m=max2f(a,b);
  auto rr=__builtin_amdgcn_permlane32_swap(__float_as_uint(m),__float_as_uint(m),false,false);
  return max2f(__uint_as_float(rr[0]),__uint_as_float(rr[1]));
}
__device__ __forceinline__ void pv(f32x16*o,int vb,bf16x8 pa0,bf16x8 pa1,bf16x8 pa2,bf16x8 pa3){
  #pragma unroll
  for(int d0=0;d0<2;++d0){s16x4 lo[4],hi[4];
    #pragma unroll
    for(int ks=0;ks<4;++ks){
      asm volatile("ds_read_b64_tr_b16 %0,%1 offset:%c2":"=&v"(lo[ks]):"v"(vb),"i"(d0*4096+ks*1024):"memory");
      asm volatile("ds_read_b64_tr_b16 %0,%1 offset:%c2":"=&v"(hi[ks]):"v"(vb),"i"(d0*4096+ks*1024+512):"memory");}
    asm volatile("s_waitcnt lgkmcnt(0)":::"memory");SBAR();
    #define PK(k) (bf16x8){lo[k][0],lo[k][1],lo[k][2],lo[k][3],hi[k][0],hi[k][1],hi[k][2],hi[k][3]}
    o[d0]=__builtin_amdgcn_mfma_f32_32x32x16_bf16(pa0,PK(0),o[d0],0,0,0);
    o[d0]=__builtin_amdgcn_mfma_f32_32x32x16_bf16(pa1,PK(1),o[d0],0,0,0);
    o[d0]=__builtin_amdgcn_mfma_f32_32x32x16_bf16(pa2,PK(2),o[d0],0,0,0);
    o[d0]=__builtin_amdgcn_mfma_f32_32x32x16_bf16(pa3,PK(3),o[d0],0,0,0);
    #undef PK
  }
}

#ifndef ATTN_STORE16
#define ATTN_STORE16(p,v) (*(u32x4*)(p)=(v))
#endif
template<int THRL> __device__ __forceinline__ void attn_unit(int b,int vh,int qb,const bf16*Q,const bf16*__restrict__ K,const bf16*__restrict__ V,bf16*O,const float*btab,char*shm,int wave_s){
  const int h=vh>>2,jm=(vh>>1)&1,cv=vh&1;
  const int tid=fresh_tid(wave_s),lane=tid&63,r32=lane&31,hi=lane>>5; const int wid=wave_s;
  const long rowbase=(long)b*SEQ; const int q0=qb*QB;
  const bf16*Qw=Q+(rowbase+q0+wid*QBLK)*QP+jm*512+h*64;
  const bf16*Kh=K+(long)((jm*BATCH+b)*8+h)*SEQ*64,*Vh=V+(long)((b*8+h)*2+cv)*SEQ*64;
  const unsigned lds0=(unsigned)(uintptr_t)shm;
  float*wsf=(float*)(shm+LDS_WS)+wid*64;
  const bf16*ksrc=Kh+(long)lane*KP+wid*8;
  const bf16*vsrc=Vh+(long)(16*(wid&3)+(lane>>2))*VP+(wid>>2)*32+(lane&3)*8;
  const unsigned kdst=lds0+LDS_K+wid*1024, vdst=lds0+LDS_V+wid*1024; unsigned fence_tmp;
  #define DMA_K(t,slot) glds16(ksrc+(long)(t)*KVBLK*KP,(unsigned)__builtin_amdgcn_readfirstlane(kdst+(slot)))
  #define DMA_V(t,slot) glds16(vsrc+(long)(t)*KVBLK*VP,(unsigned)__builtin_amdgcn_readfirstlane(vdst+(slot)))
  const int vb0=(int)(lds0+LDS_V)+((lane>>4)&1)*32+(lane&3)*8+(4*hi+((lane&15)>>2))*64;
  const char*Kbase=shm+LDS_K; bf16x8 kf[8];
  const lds_cptr shm3=(lds_cptr)shm; const lds_cptr kp0=shm3+LDS_K+hi*1024+r32*16; const lds_cptr vp0=shm3+LDS_V+((lane>>4)&1)*32+(lane&3)*8+(4*hi+((lane&15)>>2))*64;
  const __attribute__((address_space(3))) float* tabL=(const __attribute__((address_space(3))) float*)(shm3+LDS_BYTES);
  { __attribute__((address_space(3))) float* tw=(__attribute__((address_space(3))) float*)(shm3+LDS_BYTES); const int d_=tid-256; tw[tid]=(d_>=0&&d_<128)?btab[h*128+d_]:0.f; if(tid<256)tw[512+tid]=0.f; }
  const int NT=(q0+QB)/KVBLK;
  DMA_K(0,0);DMA_V(0,0);DMA_K(1,SLOTB);
  bf16x8 qr[4];
  #pragma unroll
  for(int d0=0;d0<4;++d0)qr[d0]=*reinterpret_cast<const bf16x8*>(&Qw[(long)r32*QP+d0*16+hi*8]);
  float mhat=0.f,l_reg=0.f;f32x16 o[2];o[0]=f32x16{};o[1]=f32x16{};f32x16 negm=f32x16{};asm volatile("":"+v"(negm));
  const int qrel=wid*QBLK+r32;
  #define CMASK(P0,P1,t) do{ if((t)>=NT-6+(wid>>1)&&(t)<=NT-4+(wid>>1)) addbias(P0,P1,tabL+(256+q0+qrel-64*(t)-4*hi)); int jb_=(t)-(NT-4); if(jb_>=0)cmask(P0,P1,jb_,qrel,hi);}while(0)
  bool resc=false;
  #define START(P0,P1) do{ const float rm=rowmax(P0,P1); resc=false; \
    { const float dl=rm; mhat=fadd_s(mhat,dl); \
      _Pragma("unroll") for(int r=0;r<16;++r){P0[r]=fsub_s(P0[r],dl);P1[r]=fsub_s(P1[r],dl);} \
      _Pragma("unroll") for(int r=0;r<16;++r)negm[r]=-mhat; asm volatile("":"+v"(negm)); } \
    _Pragma("unroll") for(int r=0;r<16;++r)P0[r]=__builtin_amdgcn_exp2f(P0[r]); }while(0)
  #define RESC() do{ if(resc){ asm volatile("s_waitcnt lgkmcnt(0)":::"memory"); \
      _Pragma("unroll") for(int d_=0;d_<2;++d_) _Pragma("unroll") for(int r=0;r<16;++r)o[d_][r]*=wsf[crow(r,hi)]; } }while(0)
  f32x16 pA0,pA1,pB0,pB1;
  int sl_prev=0,sl_cur=0,sl_next=SLOTB;
  #define ROT() do{sl_prev=sl_cur;sl_cur=sl_next;sl_next=(sl_next==(NSLOT-1)*SLOTB)?0:sl_next+SLOTB;}while(0)
  DMA_K(2,2*SLOTB);
  WAIT_BAR(3);
  qkt(pA0,pA1,Kbase,qr,negm,r32,hi);asm volatile("s_nop 15\n\ts_nop 7":"+v"(pA0),"+v"(pA1));CMASK(pA0,pA1,0);
  START(pA0,pA1);
  _Pragma("unroll") for(int r=0;r<16;++r)pA1[r]=__builtin_amdgcn_exp2f(pA1[r]);
  WAIT_BAR(0);
  DMA_K(3,0);DMA_V(1,SLOTB);
  ROT();
  kload8(kf,kp0+sl_cur);
  WAIT_BAR(2);
  s16x4 vlo[8],vhi[8]; u32x4 pw0,pw1,pw2,pw3;
  #define PKW(P,B) cvtpk_s(P[B],P[B+1])
  #define PAF(k) __builtin_bit_cast(bf16x8,pw##k)
  #define VFR(i) (bf16x8){vlo[i][0],vlo[i][1],vlo[i][2],vlo[i][3],vhi[i][0],vhi[i][1],vhi[i][2],vhi[i][3]}
  #define PIN(x) asm volatile("":"+v"(x))
  #define MX3(a,b,c) __builtin_fmaxf(__builtin_fmaxf((a),(b)),(c))
  #define GAPA(MF,A0,A1,A2,A3,W0,W1,PW) do{ MF; sacc+=A0; sacc+=A1; sacc+=A2; sacc+=A3; PIN(sacc); W0; W1; PIN(PW); SBAR(); }while(0)
  #define EX(v) __builtin_amdgcn_exp2f(v)
  #define GAPB(MF,X,B) do{ MF; X[B]=EX(X[B]); X[B+1]=EX(X[B+1]); X[B+2]=EX(X[B+2]); X[B+3]=EX(X[B+3]); PIN(X); SBAR(); }while(0)
  #define VRD(i) do{ vlo[i]=vtr(vp_+(((i)>>2)*4096+((i)&3)*1024)); vhi[i]=vtr(vp_+(((i)>>2)*4096+((i)&3)*1024+512)); }while(0)
  #define KRD(G,j) do{ if(G){ kload2(kf,kp0+sl_next,j); SBAR(); } }while(0)
  #define STEP(C0,C1,P0,P1,t,GK,GV,GL) do{ SBAR(); \
    const lds_cptr vp_=vp0+sl_prev; \
    VRD(0); SBAR(); float sacc=(P0[0]+P0[1]); \
    GAPA(C0=__builtin_amdgcn_mfma_f32_32x32x16_bf16(kf[0],qr[0],negm,0,0,0), P0[2],P0[3],P0[4],P0[5],     pw0[0]=PKW(P0,0), pw0[1]=PKW(P0,2), pw0); \
    VRD(4); SBAR(); GAPA(C1=__builtin_amdgcn_mfma_f32_32x32x16_bf16(kf[1],qr[0],negm,0,0,0), P0[6],P0[7],P0[8],P0[9],     pw0[2]=PKW(P0,4), pw0[3]=PKW(P0,6), pw0); \
    VRD(1); SBAR(); GAPA(C0=__builtin_amdgcn_mfma_f32_32x32x16_bf16(kf[2],qr[1],C0,0,0,0),   P0[10],P0[11],P0[12],P0[13], pw1[0]=PKW(P0,8), pw1[1]=PKW(P0,10), pw1); \
    VRD(5); SBAR(); GAPA(C1=__builtin_amdgcn_mfma_f32_32x32x16_bf16(kf[3],qr[1],C1,0,0,0),   P0[14],P0[15],P1[0],P1[1],   pw1[2]=PKW(P0,12),pw1[3]=PKW(P0,14), pw1); \
    VRD(2); SBAR(); GAPA(C0=__builtin_amdgcn_mfma_f32_32x32x16_bf16(kf[4],qr[2],C0,0,0,0),   P1[2],P1[3],P1[4],P1[5],     pw2[0]=PKW(P1,0), pw2[1]=PKW(P1,2), pw2); \
    VRD(6); SBAR(); GAPA(C1=__builtin_amdgcn_mfma_f32_32x32x16_bf16(kf[5],qr[2],C1,0,0,0),   P1[6],P1[7],P1[8],P1[9],     pw2[2]=PKW(P1,4), pw2[3]=PKW(P1,6), pw2); \
    VRD(3); SBAR(); GAPA(C0=__builtin_amdgcn_mfma_f32_32x32x16_bf16(kf[6],qr[3],C0,0,0,0),   P1[10],P1[11],P1[12],P1[13], pw3[0]=PKW(P1,8), pw3[1]=PKW(P1,10), pw3); \
    VRD(7); SBAR(); GAPA(C1=__builtin_amdgcn_mfma_f32_32x32x16_bf16(kf[7],qr[3],C1,0,0,0),   P1[14],P1[15],0.f,0.f,       pw3[2]=PKW(P1,12),pw3[3]=PKW(P1,14), pw3); \
    l_reg+=sacc; \
    if(GK){DMA_K((t)+3,sl_cur);} if(GV){DMA_V((t)+1,sl_next);} \
    CMASK(C0,C1,t); \
    { float a=MX3(C0[0],C0[1],C1[0]),b=MX3(C0[2],C0[3],C1[1]); a=MX3(a,C1[2],C1[3]); \
      _Pragma("unroll") for(int r=4;r<16;r+=4){a=MX3(a,C0[r],C0[r+1]);b=MX3(b,C0[r+2],C0[r+3]);a=MX3(a,C1[r],C1[r+1]);b=MX3(b,C1[r+2],C1[r+3]);} \
      float rm=__builtin_fmaxf(a,b); { auto rr=__builtin_amdgcn_permlane32_swap(__float_as_uint(rm),__float_as_uint(rm),false,false); rm=__builtin_fmaxf(__uint_as_float(rr[0]),__uint_as_float(rr[1])); } \
      resc=false; \
      if(__builtin_expect(__any(rm>(float)THRL),0)){ const float dl=__builtin_fmaxf(rm,0.f); mhat+=dl; \
        _Pragma("unroll") for(int r=0;r<16;++r){C0[r]-=dl;C1[r]-=dl;} \
        _Pragma("unroll") for(int r=0;r<16;++r)negm[r]=-mhat; asm volatile("":"+v"(negm)); \
        const float f=__builtin_amdgcn_exp2f(-dl); l_reg*=f; if(hi==0)wsf[r32]=f; resc=true; } } \
    SBAR(); \
    GAPB(o[0]=__builtin_amdgcn_mfma_f32_32x32x16_bf16(PAF(0),VFR(0),o[0],0,0,0), C0,0); \
    GAPB(o[1]=__builtin_amdgcn_mfma_f32_32x32x16_bf16(PAF(0),VFR(4),o[1],0,0,0), C0,4); \
    KRD(GL,0); GAPB(o[0]=__builtin_amdgcn_mfma_f32_32x32x16_bf16(PAF(1),VFR(1),o[0],0,0,0), C0,8); \
    KRD(GL,1); GAPB(o[1]=__builtin_amdgcn_mfma_f32_32x32x16_bf16(PAF(1),VFR(5),o[1],0,0,0), C0,12); \
    KRD(GL,2); GAPB(o[0]=__builtin_amdgcn_mfma_f32_32x32x16_bf16(PAF(2),VFR(2),o[0],0,0,0), C1,0); \
    KRD(GL,3); GAPB(o[1]=__builtin_amdgcn_mfma_f32_32x32x16_bf16(PAF(2),VFR(6),o[1],0,0,0), C1,4); \
    GAPB(o[0]=__builtin_amdgcn_mfma_f32_32x32x16_bf16(PAF(3),VFR(3),o[0],0,0,0), C1,8); \
    GAPB(o[1]=__builtin_amdgcn_mfma_f32_32x32x16_bf16(PAF(3),VFR(7),o[1],0,0,0), C1,12); \
    }while(0)
  int t=1;
  #undef CMASK
  #define CMASK(P0,P1,t) do{}while(0)
  for(;t+7<NT;t+=2){
    STEP(pB0,pB1,pA0,pA1,t,true,true,true);     WAIT_BAR(2); RESC(); ROT();
    STEP(pA0,pA1,pB0,pB1,t+1,true,true,true);   WAIT_BAR(2); RESC(); ROT();
  }
  #undef CMASK
  #define CMASK(P0,P1,t) do{ if((t)>=NT-6+(wid>>1)&&(t)<=NT-4+(wid>>1)) addbias(P0,P1,tabL+(256+q0+qrel-64*(t)-4*hi)); int jb_=(t)-(NT-4); if(jb_>=0)cmask(P0,P1,jb_,qrel,hi);}while(0)
  #define ENDW(tt) do{ if((tt)+3<NT){WAIT_BAR(2);} else if((tt)+2<NT){WAIT_BAR(1);} else {WAIT_BAR(0);} }while(0)
  for(;t+1<NT;t+=2){
    STEP(pB0,pB1,pA0,pA1,t,(t+3<NT),(t+1<NT),(t+1<NT));       ENDW(t);   RESC(); ROT();
    STEP(pA0,pA1,pB0,pB1,t+1,(t+4<NT),(t+2<NT),(t+2<NT));     ENDW(t+1); RESC(); ROT();
  }
  STEP(pB0,pB1,pA0,pA1,NT-1,false,false,false); RESC();
  { float sacc=pB0[0]+pB0[1]; _Pragma("unroll") for(int r=2;r<16;++r)sacc+=pB0[r]; _Pragma("unroll") for(int r=0;r<16;++r)sacc+=pB1[r]; l_reg+=sacc;
    pw0=(u32x4){PKW(pB0,0),PKW(pB0,2),PKW(pB0,4),PKW(pB0,6)};pw1=(u32x4){PKW(pB0,8),PKW(pB0,10),PKW(pB0,12),PKW(pB0,14)};pw2=(u32x4){PKW(pB1,0),PKW(pB1,2),PKW(pB1,4),PKW(pB1,6)};pw3=(u32x4){PKW(pB1,8),PKW(pB1,10),PKW(pB1,12),PKW(pB1,14)};
    SBAR(); pv(o,vb0+sl_cur,PAF(0),PAF(1),PAF(2),PAF(3)); }
  #undef PKW
  #undef PAF
  #undef VFR
  #undef PIN
  #undef MX3
  #undef GAPA
  #undef GAPB
  #undef EX
  #undef VRD
  #undef KRD
  #undef STEP
  #undef ENDW
  {auto rr=__builtin_amdgcn_permlane32_swap(__float_as_uint(l_reg),__float_as_uint(l_reg),false,false);l_reg=__uint_as_float(rr[0])+__uint_as_float(rr[1]);}
  if(hi==0)wsf[32+r32]=l_reg;asm volatile("s_waitcnt lgkmcnt(0)":::"memory");
  float rli[16];
  #pragma unroll
  for(int r=0;r<16;++r)rli[r]=__builtin_amdgcn_rcpf(wsf[32+crow(r,hi)]);
  bf16*Ow=O+(rowbase+q0+wid*QBLK)*OP+jm*1024+h*128+cv*64;
  { bf16*stg=(bf16*)(shm+LDS_OST)+wid*2048;
    #pragma unroll
    for(int r=0;r<16;++r){const int orow=crow(r,hi);
      #pragma unroll
      for(int d0=0;d0<2;++d0)stg[orow*64+d0*32+r32]=__float2bfloat16(o[d0][r]*rli[r]);}
    asm volatile("s_waitcnt lgkmcnt(0)":::"memory");
    #pragma unroll
    for(int i=0;i<4;++i){const int row=i*8+(lane>>3),ch=lane&7; const u32x4 v=*(const u32x4*)(stg+row*64+ch*8); ATTN_STORE16(Ow+(long)row*OP+ch*8,v);} }
  asm volatile("s_waitcnt lgkmcnt(0)\n\ts_barrier":::"memory");
  #undef DMA_K
  #undef DMA_V
  #undef CMASK
  #undef START
  #undef RESC
  #undef ROT
}
constexpr int ATTN_LDS_BYTES=LDS_BYTES;
struct AttnTensors { const bf16* Q; const bf16* K; const bf16* V; bf16* O; const float* btab; };
struct AttnUnit { int bh; int qb; };
struct StaticOrder {
  int vcu;
  __device__ __forceinline__ explicit StaticOrder(int grid,int block):vcu((block%8)*(grid/8)+block/8){}
  __device__ __forceinline__ bool next(int i,AttnUnit&u)const{ if(i>=16)return false; const int s=vcu&7,ii=i&3; u.bh=(vcu>>3)+32*(i>>2); u.qb=(ii==0)?s:(ii==1)?15-s:(ii==2)?16+s:31-s; return true; }
  __device__ __forceinline__ void a_ready(const AttnUnit&)const{}
  __device__ __forceinline__ void done(const AttnUnit&)const{}
};
template<class Sched,int THRL=8> __device__ __forceinline__ void attn_phase(char*lds,const AttnTensors&T,const Sched&S,int wave_s){
  AttnUnit u;
  for(int i=0;S.next(i,u);++i){ S.a_ready(u); attn_unit<THRL>(u.bh/NHEAD,u.bh%NHEAD,u.qb,T.Q,T.K,T.V,T.O,T.btab,lds,wave_s); S.done(u); }
}
#undef SBAR
#undef WAIT_BAR
}
#define LAS __attribute__((address_space(3)))
typedef unsigned short bf16_t;
typedef short bf16x8 __attribute__((ext_vector_type(8)));
typedef float f32x4 __attribute__((ext_vector_type(4)));
typedef float f32x16 __attribute__((ext_vector_type(16)));
typedef unsigned u32x4 __attribute__((ext_vector_type(4)));
typedef unsigned u32x2 __attribute__((ext_vector_type(2)));
typedef float f32x2_t __attribute__((ext_vector_type(2)));
typedef __bf16 bf16x2_t __attribute__((ext_vector_type(2)));

constexpr int BATCH = 4, SEQ = 8192, DM = 1024, MTOK = BATCH * SEQ, DFF = 2816, NFF = 2 * DFF;
constexpr float EPS = 1e-6f, LOG2E = 1.4426950408889634f;
constexpr float LAMBDA_INIT = 0.35550906f;
constexpr float QSCALE = 0.125f * LOG2E;
constexpr int NWAVES = 8, NTHR = 512;
constexpr int LDS_BYTES = 139264;

constexpr size_t MiB = 1u << 20;
constexpr size_t WS_SSQ = 496 * MiB;
constexpr size_t WS_LB = 1 * MiB;
constexpr size_t WS_BTAB = 1 * MiB + 4096;
constexpr size_t WS_LAM = 1 * MiB + 8192;
constexpr size_t WS_FI00 = 2 * MiB, WS_FI01 = 13 * MiB, WS_FO00 = 24 * MiB, WS_FO01 = 24 * MiB + 5632 * 1024, WS_HIN = 35 * MiB, WS_HOUT = 43 * MiB;
constexpr size_t WS_HB = 45 * MiB;
constexpr size_t WS_BIG = 109 * MiB;
constexpr size_t WS_HID = WS_BIG;
constexpr size_t WS_QH = WS_BIG, WS_LF = WS_BIG + 64 * MiB, WS_VH = WS_BIG + 128 * MiB, WS_GH = WS_BIG + 192 * MiB, WS_UT = WS_BIG + 256 * MiB, WS_DEC = WS_BIG + 384 * MiB;
constexpr size_t WS_W1 = 302 * MiB;
constexpr size_t WS_FI10 = WS_W1, WS_FI11 = WS_W1 + 11 * MiB, WS_FO10 = WS_W1 + 22 * MiB, WS_FO11 = WS_W1 + 22 * MiB + 5632 * 1024, WS_WKV = WS_W1 + 33 * MiB, WS_WQ = WS_W1 + 37 * MiB, WS_WAO = WS_W1 + 39 * MiB;
constexpr size_t WS_KV = 361 * MiB;
constexpr size_t WS_QB = WS_BIG;
constexpr size_t WS_OB = WS_BIG + 64 * MiB;
constexpr size_t WS_END = 511 * MiB;
static_assert(WS_DEC + 2 * MiB <= WS_SSQ && WS_KV + 128 * MiB <= WS_SSQ && WS_SSQ + (size_t)7 * MTOK * 64 <= WS_END && WS_OB + 128 * MiB <= WS_W1 && WS_WAO + 2 * MiB <= WS_KV && WS_HID + (size_t)MTOK * DFF * 2 <= WS_W1, "ws map");

__device__ __forceinline__ float bf2f(unsigned short b) { return __uint_as_float((unsigned)b << 16); }
__device__ __forceinline__ unsigned pkbf(float lo, float hi) { f32x2_t v = {lo, hi}; bf16x2_t b = __builtin_convertvector(v, bf16x2_t); return __builtin_bit_cast(unsigned, b); }
__device__ __forceinline__ unsigned short f2bf(float f) { return (unsigned short)(pkbf(f, 0.f) & 0xffffu); }
__device__ __forceinline__ float fexp(float x) { return __builtin_amdgcn_exp2f(x * LOG2E); }
__device__ __forceinline__ float sigm(float v) { return __builtin_amdgcn_rcpf(1.f + __builtin_amdgcn_exp2f(-v * LOG2E)); }
__device__ __forceinline__ float silu(float v) { return v * sigm(v); }
__device__ __forceinline__ float wave_sum(float v) {
#pragma unroll
    for (int o = 1; o < 64; o <<= 1) v += __shfl_xor(v, o);
    return v;
}
__device__ __forceinline__ int crow(int r, int hi) { return (r & 3) + 8 * (r >> 2) + 4 * hi; }

namespace epi {
using pg8::Unit;
__device__ __forceinline__ float rstd_of(const float* ssq, int row, int fq) {
    const f32x4 a = *(const f32x4*)(ssq + (size_t)row * 16 + fq * 4);
    float t = (a[0] + a[1]) + (a[2] + a[3]);
    t += __shfl_xor(t, 16); t += __shfl_xor(t, 32);
    return rsqrtf(t * (1.f / 1024.f) + EPS);
}

struct EpiSwiglu {
    static constexpr bool PERM = true, AFTER_DRAIN = false;
    bf16_t* H; const float* ssq;
    __device__ __forceinline__ void operator()(const f32x4 (&acc)[2][2][4][2], const Unit& u, int wr, int wc, int fr, int fq) const {
        const int col0 = u.pn * 128 + wc * 32 + 8 * fq;
#pragma unroll
        for (int ai = 0; ai < 2; ++ai)
#pragma unroll
            for (int m = 0; m < 4; ++m) {
                const int row = u.pm * 256 + ai * 128 + wr * 64 + m * 16 + fr; const float r = rstd_of(ssq, row, fq);
                float o[8];
#pragma unroll
                for (int n = 0; n < 2; ++n)
#pragma unroll
                    for (int e = 0; e < 4; ++e) { const float g = acc[ai][0][m][n][e] * r, uu = acc[ai][1][m][n][e] * r; o[n * 4 + e] = silu(g) * uu; }
                u32x4 w; w.x = pkbf(o[0], o[1]); w.y = pkbf(o[2], o[3]); w.z = pkbf(o[4], o[5]); w.w = pkbf(o[6], o[7]);
                *(u32x4*)(H + (size_t)row * DFF + col0) = w;
            }
    }
};
constexpr int LO_BITS = 8;
__device__ __forceinline__ float lo8_dec(unsigned hbits16, int q) {
    const unsigned eb = (hbits16 >> 7) & 0xffu; const float ulp = __uint_as_float(eb > 7u ? (eb - 7u) << 23 : 0u);
    return __uint_as_float(hbits16 << 16) + (float)q * ulp * (1.f / 254.f);
}
__device__ __forceinline__ unsigned lo8_enc(unsigned hbits16, float o) {
    const unsigned eb = (hbits16 >> 7) & 0xffu; const float inv = __uint_as_float(eb > 7u ? (261u - eb) << 23 : 0u);
    const float r = (o - __uint_as_float(hbits16 << 16)) * inv * 254.f;
    return (unsigned)(int)rintf(fminf(fmaxf(r, -127.f), 127.f)) & 0xffu;
}
template <bool BASE_F32, bool OUT_F32>
struct EpiRes {
    static constexpr bool PERM = true, AFTER_DRAIN = false;
    const float* basef; bf16_t* hi; unsigned char* lo; float* outf; float* ssq_out; float alpha;
    __device__ __forceinline__ void operator()(const f32x4 (&acc)[2][2][4][2], const Unit& u, int wr, int wc, int fr, int fq) const {
        const int col0 = u.pn * 256 + wc * 32 + 8 * fq;
#pragma unroll
        for (int ai = 0; ai < 2; ++ai)
#pragma unroll
            for (int m = 0; m < 4; ++m) {
                const int row = u.pm * 256 + ai * 128 + wr * 64 + m * 16 + fr; float s = 0.f;
#pragma unroll
                for (int bj = 0; bj < 2; ++bj) {
                    const size_t off = (size_t)row * DM + col0 + bj * 128;
                    float o[8];
                    if (BASE_F32) {
                        const f32x4 b0 = *(const f32x4*)(basef + off), b1 = *(const f32x4*)(basef + off + 4);
#pragma unroll
                        for (int e = 0; e < 4; ++e) { o[e] = b0[e]; o[4 + e] = b1[e]; }
                    } else {
                        const u32x4 hv = *(const u32x4*)(hi + off);
                        if (LO_BITS == 16) {
                            const u32x4 lv = *(const u32x4*)((const bf16_t*)lo + off);
#pragma unroll
                            for (int k = 0; k < 4; ++k) { o[2 * k] = __uint_as_float(hv[k] << 16) + __uint_as_float(lv[k] << 16); o[2 * k + 1] = __uint_as_float(hv[k] & 0xffff0000u) + __uint_as_float(lv[k] & 0xffff0000u); }
                        } else {
                            const u32x2 lv = *(const u32x2*)(lo + off);
#pragma unroll
                            for (int k = 0; k < 4; ++k) { const unsigned lw = k < 2 ? lv.x : lv.y; const int sh = (k & 1) * 16;
                                o[2 * k] = lo8_dec(hv[k] & 0xffffu, (int)(signed char)((lw >> sh) & 0xffu)); o[2 * k + 1] = lo8_dec(hv[k] >> 16, (int)(signed char)((lw >> (sh + 8)) & 0xffu)); }
                        }
                    }
#pragma unroll
                    for (int e = 0; e < 4; ++e) { o[e] += acc[ai][bj][m][0][e] * alpha; o[4 + e] += acc[ai][bj][m][1][e] * alpha; }
                    if (OUT_F32) {
                        *(f32x4*)(outf + off) = (f32x4){o[0], o[1], o[2], o[3]}; *(f32x4*)(outf + off + 4) = (f32x4){o[4], o[5], o[6], o[7]};
                    } else {
                        u32x4 hw; hw.x = pkbf(o[0], o[1]); hw.y = pkbf(o[2], o[3]); hw.z = pkbf(o[4], o[5]); hw.w = pkbf(o[6], o[7]);
                        *(u32x4*)(hi + off) = hw;
                        if (LO_BITS == 16) {
                            u32x4 lw;
#pragma unroll
                            for (int k = 0; k < 4; ++k) lw[k] = pkbf(o[2 * k] - __uint_as_float(hw[k] << 16), o[2 * k + 1] - __uint_as_float(hw[k] & 0xffff0000u));
                            *(u32x4*)((bf16_t*)lo + off) = lw;
                        } else {
                            unsigned q[8];
#pragma unroll
                            for (int k = 0; k < 4; ++k) { q[2 * k] = lo8_enc(hw[k] & 0xffffu, o[2 * k]); q[2 * k + 1] = lo8_enc(hw[k] >> 16, o[2 * k + 1]); }
                            u32x2 lw; lw.x = q[0] | (q[1] << 8) | (q[2] << 16) | (q[3] << 24); lw.y = q[4] | (q[5] << 8) | (q[6] << 16) | (q[7] << 24);
                            *(u32x2*)(lo + off) = lw;
                        }
                    }
                    s += (o[0] * o[0] + o[1] * o[1]) + (o[2] * o[2] + o[3] * o[3]) + (o[4] * o[4] + o[5] * o[5]) + (o[6] * o[6] + o[7] * o[7]);
                }
                s += __shfl_xor(s, 16); s += __shfl_xor(s, 32);
                if (fq == 0) ssq_out[(size_t)row * 16 + u.pn * 4 + wc] = s;
            }
    }
};
struct EpiBf16 {
    static constexpr bool PERM = true, AFTER_DRAIN = false;
    bf16_t* O; int ldc; const float* ssq; float scale;
    __device__ __forceinline__ void operator()(const f32x4 (&acc)[2][2][4][2], const Unit& u, int wr, int wc, int fr, int fq) const {
        const int col0 = u.pn * 256 + wc * 32 + 8 * fq;
#pragma unroll
        for (int ai = 0; ai < 2; ++ai)
#pragma unroll
            for (int m = 0; m < 4; ++m) {
                const int row = u.pm * 256 + ai * 128 + wr * 64 + m * 16 + fr; const float r = rstd_of(ssq, row, fq) * scale;
#pragma unroll
                for (int bj = 0; bj < 2; ++bj) {
                    const f32x4 v0 = acc[ai][bj][m][0] * r, v1 = acc[ai][bj][m][1] * r;
                    u32x4 w; w.x = pkbf(v0[0], v0[1]); w.y = pkbf(v0[2], v0[3]); w.z = pkbf(v1[0], v1[1]); w.w = pkbf(v1[2], v1[3]);
                    *(u32x4*)(O + (size_t)row * ldc + col0 + bj * 128) = w;
                }
            }
    }
};
struct EpiKV {
    static constexpr bool PERM = true, AFTER_DRAIN = false;
    bf16_t* KK; bf16_t* VV; const float* ssq;
    __device__ __forceinline__ void operator()(const f32x4 (&acc)[2][2][4][2], const Unit& u, int wr, int wc, int fr, int fq) const {
#pragma unroll
        for (int bj = 0; bj < 2; ++bj) {
            const int col = u.pn * 256 + bj * 128 + wc * 32 + 8 * fq;
            bf16_t* basep; size_t bstride;
            if (col < 1024) { const int j = col >> 9, h = (col >> 6) & 7; basep = KK + ((size_t)(j * BATCH * 8 + h) * SEQ) * 64 + (col & 63); bstride = (size_t)8 * SEQ * 64; }
            else { const int c2 = col - 1024, h = c2 >> 7, cv = (c2 >> 6) & 1; basep = VV + ((size_t)(h * 2 + cv) * SEQ) * 64 + (c2 & 63); bstride = (size_t)16 * SEQ * 64; }
#pragma unroll
            for (int ai = 0; ai < 2; ++ai)
#pragma unroll
                for (int m = 0; m < 4; ++m) {
                    const int row = u.pm * 256 + ai * 128 + wr * 64 + m * 16 + fr; const float r = rstd_of(ssq, row, fq);
                    const f32x4 v0 = acc[ai][bj][m][0] * r, v1 = acc[ai][bj][m][1] * r;
                    u32x4 w; w.x = pkbf(v0[0], v0[1]); w.y = pkbf(v0[2], v0[3]); w.z = pkbf(v1[0], v1[1]); w.w = pkbf(v1[2], v1[3]);
                    *(u32x4*)(basep + (size_t)(row >> 13) * bstride + (size_t)(row & (SEQ - 1)) * 64) = w;
                }
        }
    }
};
struct EpiHgrnIn {
    static constexpr bool PERM = true, AFTER_DRAIN = false;
    bf16_t* QH; unsigned short* LF; bf16_t* VH; bf16_t* GH; const float* ssq; const float* lb;
    __device__ __forceinline__ void operator()(const f32x4 (&acc)[2][2][4][2], const Unit& u, int wr, int wc, int fr, int fq) const {
        const int typ = u.pn >> 2; const int col0 = (u.pn & 3) * 256 + wc * 32 + 8 * fq;
        f32x4 lbv[2][2];
#pragma unroll
        for (int bj = 0; bj < 2; ++bj)
#pragma unroll
            for (int n = 0; n < 2; ++n) lbv[bj][n] = (typ == 1) ? *(const f32x4*)(lb + col0 + bj * 128 + 4 * n) : (f32x4){0.f, 0.f, 0.f, 0.f};
        bf16_t* dst = typ == 0 ? QH : (typ == 1 ? (bf16_t*)LF : (typ == 2 ? VH : GH));
#pragma unroll
        for (int ai = 0; ai < 2; ++ai)
#pragma unroll
            for (int m = 0; m < 4; ++m) {
                const int row = u.pm * 256 + ai * 128 + wr * 64 + m * 16 + fr; const float r = rstd_of(ssq, row, fq);
#pragma unroll
                for (int bj = 0; bj < 2; ++bj) {
                    const f32x4 v0 = acc[ai][bj][m][0] * r, v1 = acc[ai][bj][m][1] * r;
                    u32x4 w;
                    if (typ == 1) {
                        unsigned q[8];
#pragma unroll
                        for (int e = 0; e < 8; ++e) { const float x = e < 4 ? v0[e & 3] : v1[e & 3]; const float l = e < 4 ? lbv[bj][0][e & 3] : lbv[bj][1][e & 3];
                            const float f = l + (1.f - l) * sigm(x); const float nl = -__logf(f) * 32768.f; q[e] = (unsigned)fminf(fmaxf(rintf(nl), 0.f), 65535.f); }
                        w.x = q[0] | (q[1] << 16); w.y = q[2] | (q[3] << 16); w.z = q[4] | (q[5] << 16); w.w = q[6] | (q[7] << 16);
                    } else if (typ == 2) {
                        w.x = pkbf(v0[0], v0[1]); w.y = pkbf(v0[2], v0[3]); w.z = pkbf(v1[0], v1[1]); w.w = pkbf(v1[2], v1[3]);
                    } else {
                        w.x = pkbf(silu(v0[0]), silu(v0[1])); w.y = pkbf(silu(v0[2]), silu(v0[3])); w.z = pkbf(silu(v1[0]), silu(v1[1])); w.w = pkbf(silu(v1[2]), silu(v1[3]));
                    }
                    *(u32x4*)(dst + (size_t)row * DM + col0 + bj * 128) = w;
                }
            }
    }
};
}

__device__ __forceinline__ int swmap(int n) { return n < DFF ? ((n >> 7) * 256 + (n & 127)) : (((n - DFF) >> 7) * 256 + 128 + ((n - DFF) & 127)); }
__device__ __forceinline__ void transpose_item(const float* W, int K, int N, bf16_t* WT, const float* nw, int mode, LAS float* scr, int item, int lane) {
    const int nblk = N / 32, kb = item / nblk, nb = item % nblk, k0 = 64 * kb, n0 = 32 * nb;
#pragma unroll 8
    for (int i = 0; i < 32; ++i) { const int kk = 2 * i + (lane >> 5); float v = W[(size_t)(k0 + kk) * N + n0 + (lane & 31)]; if (nw) v *= nw[k0 + kk]; scr[kk * 33 + (lane & 31)] = v; }
    asm volatile("s_waitcnt lgkmcnt(0)" ::: "memory");
    const int c = lane & 7; const int r0 = mode ? swmap(n0) : n0;
#pragma unroll
    for (int j = 0; j < 4; ++j) { const int n = (lane >> 3) + 8 * j; const LAS float* s = scr + (8 * c) * 33 + n;
        u32x4 o; o.x = pkbf(s[0 * 33], s[1 * 33]); o.y = pkbf(s[2 * 33], s[3 * 33]); o.z = pkbf(s[4 * 33], s[5 * 33]); o.w = pkbf(s[6 * 33], s[7 * 33]);
        *(u32x4*)(WT + (size_t)(r0 + n) * K + k0 + 8 * c) = o; }
    asm volatile("s_waitcnt lgkmcnt(0)" ::: "memory");
}
__device__ __forceinline__ void convert_weight(const float* W, int K, int N, bf16_t* WT, const float* nw, int mode, LAS float* scr, int gw, int ngw, int lane) {
    const int nitems = (K / 64) * (N / 32);
    for (int it = gw; it < nitems; it += ngw) transpose_item(W, K, N, WT, nw, mode, scr, it, lane);
}

namespace hg {
constexpr int C = 64, NCH = SEQ / C, NUNIT = BATCH * 8 * NCH;
constexpr int RS = 272, RT = 144;
constexpr int L_QD = 0, L_QI = 64 * RS, L_KI = 2 * 64 * RS, L_SP = 3 * 64 * RS, L_VT = L_SP + 128 * RS, L_AM = L_VT + 128 * RT, L_PART = L_AM + 64 * RT, L_END = L_PART + 2048;
constexpr int L1_KDT = 0, L1_VT = 128 * RT, L1_PART = 2 * 128 * RT;
static_assert(L_END <= 131072, "hgrn lds");

__device__ __forceinline__ void raw16(const unsigned short* P, int unit, int tid, unsigned short (&r)[16]) {
    const int b = unit >> 10, h = (unit >> 7) & 7, n = unit & 127, dk = tid & 127, cq = tid >> 7;
    const unsigned short* p = P + ((size_t)b * SEQ + (size_t)n * C + 16 * cq) * DM + h * 128 + dk;
#pragma unroll
    for (int i = 0; i < 16; ++i) r[i] = p[(size_t)i * DM];
}
__device__ __forceinline__ void bcum_of(const unsigned short (&raw)[16], int dk, int cq, LAS float* part, float (&lf)[16], float (&bc)[16], float& bmid, float& blast) {
#pragma unroll
    for (int i = 0; i < 16; ++i) lf[i] = -(float)raw[i] * (1.f / 32768.f);
    float run = 0.f;
#pragma unroll
    for (int i = 0; i < 16; ++i) { run += lf[i]; bc[i] = run; }
    part[cq * 128 + dk] = run;
    __syncthreads();
    const float p0 = part[dk], p1 = part[128 + dk], p2 = part[256 + dk], p3 = part[384 + dk];
    const float off = cq == 0 ? 0.f : (cq == 1 ? p0 : (cq == 2 ? p0 + p1 : p0 + p1 + p2));
    bmid = p0 + p1; blast = (p0 + p1) + (p2 + p3);
#pragma unroll
    for (int i = 0; i < 16; ++i) bc[i] += off;
}
__device__ __forceinline__ void stage_vt(const unsigned short (&v)[16], int dv, int cq, LAS unsigned char* vt) {
    u32x4 a, b;
    a.x = v[0] | ((unsigned)v[1] << 16); a.y = v[2] | ((unsigned)v[3] << 16); a.z = v[4] | ((unsigned)v[5] << 16); a.w = v[6] | ((unsigned)v[7] << 16);
    b.x = v[8] | ((unsigned)v[9] << 16); b.y = v[10] | ((unsigned)v[11] << 16); b.z = v[12] | ((unsigned)v[13] << 16); b.w = v[14] | ((unsigned)v[15] << 16);
    *(LAS u32x4*)(vt + dv * RT + cq * 32) = a; *(LAS u32x4*)(vt + dv * RT + cq * 32 + 16) = b;
}
__device__ __forceinline__ void h1_phase(LAS unsigned char* L, const unsigned short* LF, const bf16_t* VH, bf16_t* UT, float* DEC, int wave_s) {
    const int tid = fresh_tid(wave_s), lane = tid & 63, w = wave_s, dk = tid & 127, cq = tid >> 7, r32 = lane & 31, hi = lane >> 5;
    unsigned short rlf[16], rv[16];
    if ((int)blockIdx.x < NUNIT) { raw16(LF, blockIdx.x, tid, rlf); raw16(VH, blockIdx.x, tid, rv); }
    for (int unit = blockIdx.x; unit < NUNIT; unit += gridDim.x) {
        float lf[16], bc[16], bmid, blast;
        bcum_of(rlf, dk, cq, (LAS float*)(L + L1_PART), lf, bc, bmid, blast);
        unsigned pk[8];
#pragma unroll
        for (int i = 0; i < 16; i += 2) { const float k0 = (1.f - fexp(lf[i])) * fexp(blast - bc[i]), k1 = (1.f - fexp(lf[i + 1])) * fexp(blast - bc[i + 1]); pk[i >> 1] = pkbf(k0, k1); }
        *(LAS u32x4*)(L + L1_KDT + dk * RT + cq * 32) = (u32x4){pk[0], pk[1], pk[2], pk[3]};
        *(LAS u32x4*)(L + L1_KDT + dk * RT + cq * 32 + 16) = (u32x4){pk[4], pk[5], pk[6], pk[7]};
        stage_vt(rv, dk, cq, L + L1_VT);
        if (cq == 3) DEC[(size_t)unit * 128 + dk] = fexp(blast);
        __syncthreads();
        { const int nu = unit + (int)gridDim.x; if (nu < NUNIT) { raw16(LF, nu, tid, rlf); raw16(VH, nu, tid, rv); } }
        const int dvb = (w & 3) * 32, dkb = (w >> 2) * 64;
        f32x16 acc[2]; acc[0] = f32x16{}; acc[1] = f32x16{};
#pragma unroll
        for (int kk = 0; kk < 4; ++kk) {
            const bf16x8 a = *(const LAS bf16x8*)(L + L1_VT + (dvb + r32) * RT + (kk * 16 + 8 * hi) * 2);
#pragma unroll
            for (int t = 0; t < 2; ++t) { const bf16x8 bb = *(const LAS bf16x8*)(L + L1_KDT + (dkb + 32 * t + r32) * RT + (kk * 16 + 8 * hi) * 2);
                acc[t] = __builtin_amdgcn_mfma_f32_32x32x16_bf16(a, bb, acc[t], 0, 0, 0); }
        }
        bf16_t* up = UT + (size_t)unit * 16384;
#pragma unroll
        for (int t = 0; t < 2; ++t)
#pragma unroll
            for (int r = 0; r < 16; ++r) up[(dvb + crow(r, hi)) * 128 + dkb + 32 * t + r32] = f2bf(acc[t][r]);
        __syncthreads();
    }
}
__device__ __forceinline__ void scan_phase(bf16_t* UT, const float* DEC, int wave_s) {
    const int gt = blockIdx.x * NTHR + fresh_tid(wave_s), ngt = gridDim.x * NTHR;
    for (int g = gt; g < 32 * 4096; g += ngt) {
        const int bh = g >> 12, e = (g & 4095) * 4, dk = e & 127;
        float s0 = 0.f, s1 = 0.f, s2 = 0.f, s3 = 0.f;
        bf16_t* up = UT + (size_t)bh * 128 * 16384 + e; const float* dp = DEC + (size_t)bh * 128 * 128 + dk;
        for (int n0 = 0; n0 < NCH; n0 += 8) {
            u32x2 uu[8]; f32x4 dd[8];
#pragma unroll
            for (int j = 0; j < 8; ++j) { uu[j] = *(const u32x2*)(up + (size_t)(n0 + j) * 16384); dd[j] = *(const f32x4*)(dp + (size_t)(n0 + j) * 128); }
#pragma unroll
            for (int j = 0; j < 8; ++j) {
                u32x2 o; o.x = pkbf(s0, s1); o.y = pkbf(s2, s3);
                *(u32x2*)(up + (size_t)(n0 + j) * 16384) = o;
                s0 = dd[j][0] * s0 + __uint_as_float(uu[j].x << 16); s1 = dd[j][1] * s1 + __uint_as_float(uu[j].x & 0xffff0000u);
                s2 = dd[j][2] * s2 + __uint_as_float(uu[j].y << 16); s3 = dd[j][3] * s3 + __uint_as_float(uu[j].y & 0xffff0000u);
            }
        }
    }
}
__device__ __forceinline__ void h3_load_sp(const bf16_t* SP, int unit, int tid, u32x4 (&sp)[4]) {
    const bf16_t* p = SP + (size_t)unit * 16384;
#pragma unroll
    for (int j = 0; j < 4; ++j) { const int idx = tid + 512 * j; sp[j] = *(const u32x4*)(p + (idx >> 4) * 128 + (idx & 15) * 8); }
}
__device__ __forceinline__ void h3_phase(LAS unsigned char* L, bf16_t* QH, const unsigned short* LF, const bf16_t* VH, const bf16_t* GH, const bf16_t* SP, const float* gnw, int wave_s) {
    const int tid = fresh_tid(wave_s), lane = tid & 63, w = wave_s, dk = tid & 127, cq = tid >> 7, r32 = lane & 31, hi = lane >> 5;
    unsigned short rlf[16], rv[16], rq[16]; u32x4 rsp[4];
    if ((int)blockIdx.x < NUNIT) { raw16(LF, blockIdx.x, tid, rlf); raw16(VH, blockIdx.x, tid, rv); raw16(QH, blockIdx.x, tid, rq); h3_load_sp(SP, blockIdx.x, tid, rsp); }
    for (int unit = blockIdx.x; unit < NUNIT; unit += gridDim.x) {
        const int b = unit >> 10, h = (unit >> 7) & 7, n = unit & 127; const size_t row0 = (size_t)b * SEQ + (size_t)n * C;
#pragma unroll
        for (int j = 0; j < 4; ++j) { const int idx = tid + 512 * j; *(LAS u32x4*)(L + L_SP + (idx >> 4) * RS + (idx & 15) * 16) = rsp[j]; }
        stage_vt(rv, dk, cq, L + L_VT);
        {
            float lf[16], bc[16], bmid, blast;
            bcum_of(rlf, dk, cq, (LAS float*)(L + L_PART), lf, bc, bmid, blast);
#pragma unroll
            for (int i = 0; i < 16; ++i) {
                const float q = bf2f(rq[i]); const float k = 1.f - fexp(lf[i]);
                const int c = 16 * cq + i;
                *(LAS unsigned short*)(L + L_QD + c * RS + dk * 2) = f2bf(q * fexp(bc[i]));
                *(LAS unsigned short*)(L + L_QI + c * RS + dk * 2) = f2bf(q * fexp(bc[i] - bmid));
                *(LAS unsigned short*)(L + L_KI + c * RS + dk * 2) = f2bf(k * fexp(bmid - bc[i]));
            }
        }
        __syncthreads();
        { const int nu = unit + (int)gridDim.x; if (nu < NUNIT) { raw16(LF, nu, tid, rlf); raw16(VH, nu, tid, rv); raw16(QH, nu, tid, rq); h3_load_sp(SP, nu, tid, rsp); } }
        const int ec = tid >> 3, eseg = tid & 7; const size_t eoff = (row0 + ec) * DM + h * 128 + eseg * 16;
        const u32x4 g0 = *(const u32x4*)(GH + eoff), g1 = *(const u32x4*)(GH + eoff + 8);
        if (w < 4) {
            const int cb = (w & 1) * 32, cpb = (w >> 1) * 32;
            f32x16 a = f32x16{};
            if (!(cb == 0 && cpb == 32)) {
#pragma unroll
                for (int kk = 0; kk < 8; ++kk) {
                    const bf16x8 fa = *(const LAS bf16x8*)(L + L_QI + (cb + r32) * RS + (kk * 16 + 8 * hi) * 2);
                    const bf16x8 fb = *(const LAS bf16x8*)(L + L_KI + (cpb + r32) * RS + (kk * 16 + 8 * hi) * 2);
                    a = __builtin_amdgcn_mfma_f32_32x32x16_bf16(fa, fb, a, 0, 0, 0);
                }
            }
#pragma unroll
            for (int r = 0; r < 16; ++r) { const int c = cb + crow(r, hi), cp = cpb + r32; *(LAS unsigned short*)(L + L_AM + c * RT + cp * 2) = f2bf(cp <= c ? a[r] : 0.f); }
        }
        const int cb = (w & 1) * 32, dvb = (w >> 1) * 32;
        f32x16 o = f32x16{};
#pragma unroll
        for (int kk = 0; kk < 8; ++kk) {
            const bf16x8 fa = *(const LAS bf16x8*)(L + L_QD + (cb + r32) * RS + (kk * 16 + 8 * hi) * 2);
            const bf16x8 fb = *(const LAS bf16x8*)(L + L_SP + (dvb + r32) * RS + (kk * 16 + 8 * hi) * 2);
            o = __builtin_amdgcn_mfma_f32_32x32x16_bf16(fa, fb, o, 0, 0, 0);
        }
        __syncthreads();
#pragma unroll
        for (int kk = 0; kk < 4; ++kk) {
            const bf16x8 fa = *(const LAS bf16x8*)(L + L_AM + (cb + r32) * RT + (kk * 16 + 8 * hi) * 2);
            const bf16x8 fb = *(const LAS bf16x8*)(L + L_VT + (dvb + r32) * RT + (kk * 16 + 8 * hi) * 2);
            o = __builtin_amdgcn_mfma_f32_32x32x16_bf16(fa, fb, o, 0, 0, 0);
        }
        __syncthreads();
        LAS float* OF = (LAS float*)(L + L_QD);
#pragma unroll
        for (int r = 0; r < 16; ++r) OF[(cb + crow(r, hi)) * 132 + dvb + r32] = o[r];
        __syncthreads();
        {
            f32x4 v[4]; float ss = 0.f;
#pragma unroll
            for (int j = 0; j < 4; ++j) { v[j] = *(const LAS f32x4*)(OF + ec * 132 + eseg * 16 + 4 * j); ss += (v[j][0] * v[j][0] + v[j][1] * v[j][1]) + (v[j][2] * v[j][2] + v[j][3] * v[j][3]); }
            ss += __shfl_xor(ss, 1); ss += __shfl_xor(ss, 2); ss += __shfl_xor(ss, 4);
            const float rs = rsqrtf(ss * (1.f / 128.f) + EPS);
            const unsigned gg[8] = {g0.x, g0.y, g0.z, g0.w, g1.x, g1.y, g1.z, g1.w};
            unsigned ow[8];
#pragma unroll
            for (int j = 0; j < 4; ++j) {
                const f32x4 wv = *(const f32x4*)(gnw + eseg * 16 + 4 * j);
                const float a0 = v[j][0] * rs * wv[0] * __uint_as_float(gg[2 * j] << 16), a1 = v[j][1] * rs * wv[1] * __uint_as_float(gg[2 * j] & 0xffff0000u);
                const float a2 = v[j][2] * rs * wv[2] * __uint_as_float(gg[2 * j + 1] << 16), a3 = v[j][3] * rs * wv[3] * __uint_as_float(gg[2 * j + 1] & 0xffff0000u);
                ow[2 * j] = pkbf(a0, a1); ow[2 * j + 1] = pkbf(a2, a3);
            }
            *(u32x4*)(QH + eoff) = (u32x4){ow[0], ow[1], ow[2], ow[3]}; *(u32x4*)(QH + eoff + 8) = (u32x4){ow[4], ow[5], ow[6], ow[7]};
        }
        __syncthreads();
    }
}
}

__device__ __forceinline__ void x_prologue(const float* x, bf16_t* hb, float* ssq0, int gw, int ngw, int lane) {
    for (int m = gw; m < MTOK; m += ngw) {
        const f32x4* xr = (const f32x4*)(x + (size_t)m * DM) + lane; f32x4 v[4]; float s = 0.f;
#pragma unroll
        for (int j = 0; j < 4; ++j) { v[j] = xr[64 * j]; s += (v[j][0] * v[j][0] + v[j][1] * v[j][1]) + (v[j][2] * v[j][2] + v[j][3] * v[j][3]); }
        s = wave_sum(s);
        u32x2* o = (u32x2*)(hb + (size_t)m * DM) + lane;
#pragma unroll
        for (int j = 0; j < 4; ++j) { u32x2 w; w.x = pkbf(v[j][0], v[j][1]); w.y = pkbf(v[j][2], v[j][3]); o[64 * j] = w; }
        if (lane < 16) ssq0[(size_t)m * 16 + lane] = lane == 0 ? s : 0.f;
    }
}
__device__ __forceinline__ void combine_phase(const bf16_t* OB, bf16_t* AO, const float* subw, const float* lamp, int wave_s) {
    const float lam = __hip_atomic_load(lamp, __ATOMIC_RELAXED, __HIP_MEMORY_SCOPE_AGENT);
    const int gt = blockIdx.x * NTHR + fresh_tid(wave_s), ngt = gridDim.x * NTHR;
    const int sub = gt & 15;
    f32x4 w0 = *(const f32x4*)(subw + sub * 8), w1 = *(const f32x4*)(subw + sub * 8 + 4);
    for (int g = gt >> 4; g < MTOK * 8; g += ngt >> 4) {
        const int row = g >> 3, h = g & 7;
        const u32x4 a = *(const u32x4*)(OB + (size_t)row * 2048 + h * 128 + sub * 8), bq = *(const u32x4*)(OB + (size_t)row * 2048 + 1024 + h * 128 + sub * 8);
        const unsigned aa[4] = {a.x, a.y, a.z, a.w}, bb[4] = {bq.x, bq.y, bq.z, bq.w};
        float o[8]; float ss = 0.f;
#pragma unroll
        for (int j = 0; j < 4; ++j) { o[2 * j] = __uint_as_float(aa[j] << 16) - lam * __uint_as_float(bb[j] << 16); o[2 * j + 1] = __uint_as_float(aa[j] & 0xffff0000u) - lam * __uint_as_float(bb[j] & 0xffff0000u);
            ss += o[2 * j] * o[2 * j] + o[2 * j + 1] * o[2 * j + 1]; }
        ss += __shfl_xor(ss, 1); ss += __shfl_xor(ss, 2); ss += __shfl_xor(ss, 4); ss += __shfl_xor(ss, 8);
        const float rs = rsqrtf(ss * (1.f / 128.f) + EPS) * (1.f - LAMBDA_INIT);
        u32x4 wv; wv.x = pkbf(o[0] * rs * w0[0], o[1] * rs * w0[1]); wv.y = pkbf(o[2] * rs * w0[2], o[3] * rs * w0[3]); wv.z = pkbf(o[4] * rs * w1[0], o[5] * rs * w1[1]); wv.w = pkbf(o[6] * rs * w1[2], o[7] * rs * w1[3]);
        *(u32x4*)(AO + (size_t)row * DM + h * 128 + sub * 8) = wv;
    }
}
__device__ __forceinline__ void final_norm(const float* src, float* out, const float* fw, int gw, int ngw, int lane) {
    f32x4 wv[4];
#pragma unroll
    for (int j = 0; j < 4; ++j) wv[j] = *((const f32x4*)fw + lane + 64 * j);
    for (int m = gw; m < MTOK; m += ngw) {
        const f32x4* xr = (const f32x4*)(src + (size_t)m * DM) + lane; f32x4* orow = (f32x4*)(out + (size_t)m * DM) + lane; f32x4 v[4]; float s = 0.f;
#pragma unroll
        for (int j = 0; j < 4; ++j) { v[j] = xr[64 * j]; s += (v[j][0] * v[j][0] + v[j][1] * v[j][1]) + (v[j][2] * v[j][2] + v[j][3] * v[j][3]); }
        const float rs = rsqrtf(wave_sum(s) * (1.f / 1024.f) + EPS);
#pragma unroll
        for (int j = 0; j < 4; ++j) orow[64 * j] = v[j] * rs * wv[j];
    }
}
__device__ __forceinline__ int t5_bucket(int n) {
    if (n < 16) return n;
    const float nf = (float)n; int large = 16 + (int)(logf(nf / 16.f) / 2.0794415416798357f * 16.f);
    return large < 31 ? large : 31;
}

struct Args { const float* in[16]; float* out; unsigned char* ws; int ph_lo, ph_hi, coop, pad; };
constexpr int N_PHASES = 19;
#define PROBE_LO (-1)
#define PROBE_HI (-1)
#define PROBE_MULT 4

__global__ void __launch_bounds__(NTHR, 2) yoco_fwd(Args args) {
    extern __shared__ __attribute__((aligned(16))) unsigned char lds[];
    LAS unsigned char* L = (LAS unsigned char*)lds;
    const int wave = __builtin_amdgcn_readfirstlane(threadIdx.x >> 6);
    const int G = gridDim.x, gw = blockIdx.x * NWAVES + wave, ngw = G * NWAVES;
    unsigned char* ws = args.ws;
    const float* x = args.in[0]; const float* norm_w = args.in[1]; const float* ffn_w_in = args.in[2]; const float* ffn_w_out = args.in[3];
    float* ssq = (float*)(ws + WS_SSQ); float* lbv = (float*)(ws + WS_LB); float* btab = (float*)(ws + WS_BTAB); float* lamp = (float*)(ws + WS_LAM);
    bf16_t* HB = (bf16_t*)(ws + WS_HB); bf16_t* HID = (bf16_t*)(ws + WS_HID); float* OUT = args.out;
    const int lo = args.ph_lo, hi = args.ph_hi;
    cg::grid_group grid = cg::this_grid();
#define IN(k) (lo <= (k) && (k) < hi)
#define SEAM(k) do { if (args.coop && IN(k) && IN((k) + 1)) { asm volatile("s_waitcnt vmcnt(0) lgkmcnt(0)" ::: "memory"); grid.sync(); \
        if (wave == 0) asm volatile("s_waitcnt vmcnt(0)" ::: "memory"); __syncthreads(); } } while (0)
#define GEMM_PHASE(EPI, Aptr, Bptr, NN, KK, ...) do { pg8::Gemm g_{(const bf16_t*)(Aptr), (const bf16_t*)(Bptr), MTOK, (NN), (KK)}; pg8::StaticOrder S_; S_.init(MTOK, (NN), G, (int)blockIdx.x); \
        EPI E_{__VA_ARGS__}; pg8::gemm_phase<EPI, pg8::StaticOrder, true, true>(L, g_, S_, E_, wave); } while (0)
    LAS float* scr = (LAS float*)(L + wave * 16384);
    typedef epi::EpiRes<true, false> EpiRes0; typedef epi::EpiRes<false, false> EpiResM; typedef epi::EpiRes<false, true> EpiResL;
    unsigned char* LO = (unsigned char*)args.out;
    float* HF = (float*)(ws + WS_KV);

    unsigned long long pt_s = 0, pt_acc = 0;
#define PB(k) do { if ((k) == PROBE_LO) pt_s = __builtin_amdgcn_s_memrealtime(); } while (0)
#define PE(k) do { if ((k) == PROBE_HI) pt_acc = __builtin_amdgcn_s_memrealtime() - pt_s; } while (0)
    PB(0);
    if (IN(0)) {
        const int tid = fresh_tid(wave), lane = tid & 63;
        convert_weight(ffn_w_in, 1024, NFF, (bf16_t*)(ws + WS_FI00), norm_w + 0 * 1024, 1, scr, gw, ngw, lane);
        convert_weight(ffn_w_in + (size_t)1 * 1024 * NFF, 1024, NFF, (bf16_t*)(ws + WS_FI01), norm_w + 2 * 1024, 1, scr, gw, ngw, lane);
        convert_weight(ffn_w_out, DFF, 1024, (bf16_t*)(ws + WS_FO00), nullptr, 0, scr, gw, ngw, lane);
        convert_weight(ffn_w_out + (size_t)1 * DFF * 1024, DFF, 1024, (bf16_t*)(ws + WS_FO01), nullptr, 0, scr, gw, ngw, lane);
        convert_weight(args.in[4], 1024, 4096, (bf16_t*)(ws + WS_HIN), norm_w + 1 * 1024, 0, scr, gw, ngw, lane);
        convert_weight(args.in[7], 1024, 1024, (bf16_t*)(ws + WS_HOUT), nullptr, 0, scr, gw, ngw, lane);
        x_prologue(x, HB, ssq, gw, ngw, lane);
        if (blockIdx.x == 0) {
            const float* hlb = args.in[5];
            for (int i = tid; i < 1024; i += NTHR) { const float a0 = hlb[i], a1 = hlb[1024 + i]; lbv[i] = 1.f / (1.f + expf(a1 - a0)); }
            const float* rb = args.in[10];
            for (int i = tid; i < 1024; i += NTHR) { const int h = i >> 7, d = i & 127; btab[i] = (rb[t5_bucket(d) * 8 + h] - rb[31 * 8 + h]) * LOG2E; }
            if (wave == 0) { const float* lp = args.in[12]; const float a = wave_sum(lp[lane] * lp[64 + lane]), b2 = wave_sum(lp[128 + lane] * lp[192 + lane]);
                if (lane == 0) *lamp = expf(a) - expf(b2) + LAMBDA_INIT; }
        }
    }
    SEAM(0); PE(0); PB(1);
    if (IN(1)) GEMM_PHASE(epi::EpiSwiglu, HB, ws + WS_FI00, NFF, 1024, HID, ssq + (size_t)0 * MTOK * 16);
    SEAM(1); PE(1); PB(2);
    if (IN(2)) GEMM_PHASE(EpiRes0, HID, ws + WS_FO00, 1024, DFF, x, HB, LO, nullptr, ssq + (size_t)1 * MTOK * 16, 0.5f);
    SEAM(2); PE(2); PB(3);
    if (IN(3)) GEMM_PHASE(epi::EpiHgrnIn, HB, ws + WS_HIN, 4096, 1024, (bf16_t*)(ws + WS_QH), (unsigned short*)(ws + WS_LF), (bf16_t*)(ws + WS_VH), (bf16_t*)(ws + WS_GH), ssq + (size_t)1 * MTOK * 16, lbv);
    SEAM(3); PE(3); PB(4);
    if (IN(4)) hg::h1_phase(L, (const unsigned short*)(ws + WS_LF), (const bf16_t*)(ws + WS_VH), (bf16_t*)(ws + WS_UT), (float*)(ws + WS_DEC), wave);
    SEAM(4); PE(4); PB(5);
    if (IN(5)) hg::scan_phase((bf16_t*)(ws + WS_UT), (const float*)(ws + WS_DEC), wave);
    SEAM(5); PE(5); PB(6);
    if (IN(6)) hg::h3_phase(L, (bf16_t*)(ws + WS_QH), (const unsigned short*)(ws + WS_LF), (const bf16_t*)(ws + WS_VH), (const bf16_t*)(ws + WS_GH), (const bf16_t*)(ws + WS_UT), args.in[6], wave);
    SEAM(6); PE(6); PB(7);
    if (IN(7)) GEMM_PHASE(EpiResM, ws + WS_QH, ws + WS_HOUT, 1024, 1024, nullptr, HB, LO, nullptr, ssq + (size_t)2 * MTOK * 16, 1.0f);
    SEAM(7); PE(7); PB(8);
    if (IN(8)) {
        GEMM_PHASE(epi::EpiSwiglu, HB, ws + WS_FI01, NFF, 1024, HID, ssq + (size_t)2 * MTOK * 16);
        const int lane = fresh_tid(wave) & 63;
        convert_weight(ffn_w_in + (size_t)2 * 1024 * NFF, 1024, NFF, (bf16_t*)(ws + WS_FI10), norm_w + 3 * 1024, 1, scr, gw, ngw, lane);
        convert_weight(ffn_w_in + (size_t)3 * 1024 * NFF, 1024, NFF, (bf16_t*)(ws + WS_FI11), norm_w + 5 * 1024, 1, scr, gw, ngw, lane);
        convert_weight(ffn_w_out + (size_t)2 * DFF * 1024, DFF, 1024, (bf16_t*)(ws + WS_FO10), nullptr, 0, scr, gw, ngw, lane);
        convert_weight(ffn_w_out + (size_t)3 * DFF * 1024, DFF, 1024, (bf16_t*)(ws + WS_FO11), nullptr, 0, scr, gw, ngw, lane);
        convert_weight(args.in[9], 1024, 2048, (bf16_t*)(ws + WS_WKV), args.in[8], 0, scr, gw, ngw, lane);
        convert_weight(args.in[11], 1024, 1024, (bf16_t*)(ws + WS_WQ), norm_w + 4 * 1024, 0, scr, gw, ngw, lane);
        convert_weight(args.in[14], 1024, 1024, (bf16_t*)(ws + WS_WAO), nullptr, 0, scr, gw, ngw, lane);
    }
    SEAM(8); PE(8); PB(9);
    if (IN(9)) GEMM_PHASE(EpiResM, HID, ws + WS_FO01, 1024, DFF, nullptr, HB, LO, nullptr, ssq + (size_t)3 * MTOK * 16, 0.5f);
    SEAM(9); PE(9); PB(10);
    if (IN(10)) {
        GEMM_PHASE(epi::EpiKV, HB, ws + WS_WKV, 2048, 1024, (bf16_t*)(ws + WS_KV), (bf16_t*)(ws + WS_KV + 64 * MiB), ssq + (size_t)3 * MTOK * 16);
        GEMM_PHASE(epi::EpiSwiglu, HB, ws + WS_FI10, NFF, 1024, HID, ssq + (size_t)3 * MTOK * 16);
    }
    SEAM(10); PE(10); PB(11);
    if (IN(11)) GEMM_PHASE(EpiResM, HID, ws + WS_FO10, 1024, DFF, nullptr, HB, LO, nullptr, ssq + (size_t)4 * MTOK * 16, 0.5f);
    SEAM(11); PE(11); PB(12);
    if (IN(12)) GEMM_PHASE(epi::EpiBf16, HB, ws + WS_WQ, 1024, 1024, (bf16_t*)(ws + WS_QB), 1024, ssq + (size_t)4 * MTOK * 16, QSCALE);
    SEAM(12); PE(12); PB(13);
    if (IN(13)) {
        const attn_body::AttnTensors AT{(const attn_body::bf16*)(ws + WS_QB), (const attn_body::bf16*)(ws + WS_KV), (const attn_body::bf16*)(ws + WS_KV + 64 * MiB), (attn_body::bf16*)(ws + WS_OB), btab};
        const attn_body::StaticOrder S((int)G, (int)blockIdx.x);
        attn_body::attn_phase<attn_body::StaticOrder>((char*)lds, AT, S, wave);
    }
    SEAM(13); PE(13); PB(14);
    if (IN(14)) combine_phase((const bf16_t*)(ws + WS_OB), (bf16_t*)(ws + WS_QB), args.in[13], lamp, wave);
    SEAM(14); PE(14); PB(15);
    if (IN(15)) GEMM_PHASE(EpiResM, ws + WS_QB, ws + WS_WAO, 1024, 1024, nullptr, HB, LO, nullptr, ssq + (size_t)5 * MTOK * 16, 1.0f);
    SEAM(15); PE(15); PB(16);
    if (IN(16)) GEMM_PHASE(epi::EpiSwiglu, HB, ws + WS_FI11, NFF, 1024, HID, ssq + (size_t)5 * MTOK * 16);
    SEAM(16); PE(16); PB(17);
    if (IN(17)) GEMM_PHASE(EpiResL, HID, ws + WS_FO11, 1024, DFF, nullptr, HB, LO, HF, ssq + (size_t)6 * MTOK * 16, 0.5f);
    SEAM(17); PE(17); PB(18);
    if (IN(18)) final_norm(HF, OUT, args.in[15], gw, ngw, fresh_tid(wave) & 63);
    PE(18);
    if (PROBE_LO >= 0) { const unsigned long long t0_ = __builtin_amdgcn_s_memrealtime(); while (__builtin_amdgcn_s_memrealtime() - t0_ < PROBE_MULT * pt_acc) __builtin_amdgcn_s_sleep(8); }
#undef IN
#undef SEAM
#undef GEMM_PHASE
}

#ifndef MK_COOP
#define MK_COOP 1
#endif
extern "C" void kernel_launch(void* const* d_in, const int* in_sizes, int n_in, void* d_out, int out_size, void* d_ws, size_t ws_size, hipStream_t stream) {
    static int grid = 0;
    if (grid == 0) {
        if (n_in != 16 || in_sizes[0] != MTOK * DM || out_size != MTOK * DM || ws_size < WS_END) { fprintf(stderr, "kernel_launch: unexpected shapes (n_in %d, in0 %d, out %d, ws %zu)\n", n_in, n_in > 0 ? in_sizes[0] : -1, out_size, ws_size); grid = -1; return; }
        int dev = 0, cus = 0, per_cu = 0;
        hipGetDevice(&dev); hipDeviceGetAttribute(&cus, hipDeviceAttributeMultiprocessorCount, dev);
        hipFuncSetAttribute((const void*)yoco_fwd, hipFuncAttributeMaxDynamicSharedMemorySize, LDS_BYTES);
        hipOccupancyMaxActiveBlocksPerMultiprocessor(&per_cu, (const void*)yoco_fwd, NTHR, LDS_BYTES);
        if (per_cu < 1) { fprintf(stderr, "kernel_launch: occupancy query says %d blocks per CU\n", per_cu); per_cu = 1; }
        (void)hipGetLastError();
        grid = cus;
        if (grid > 256) grid = 256;
        grid &= ~7;
    }
    if (grid <= 0) return;
    Args a{};
    for (int i = 0; i < 16; ++i) a.in[i] = (const float*)d_in[i];
    a.out = (float*)d_out; a.ws = (unsigned char*)d_ws;
#if MK_COOP
    a.ph_lo = 0; a.ph_hi = N_PHASES; a.coop = 1;
    void* kargs[] = {&a};
    hipError_t e = hipLaunchCooperativeKernel((const void*)yoco_fwd, dim3(grid), dim3(NTHR), kargs, LDS_BYTES, stream);
    if (e != hipSuccess) fprintf(stderr, "cooperative launch failed: %s (grid %d)\n", hipGetErrorString(e), grid);
#else
    for (int p = 0; p < N_PHASES; ++p) { a.ph_lo = p; a.ph_hi = p + 1; a.coop = 0; hipLaunchKernelGGL(yoco_fwd, dim3(grid), dim3(NTHR), LDS_BYTES, stream, a); }
#endif
}
```

```cpp
#include <hip/hip_runtime.h>
#include <hip/hip_bf16.h>
#include <hip/hip_cooperative_groups.h>
#include <cstdio>
#include <cstdint>
#include <cmath>
namespace cg = cooperative_groups;
__device__ __forceinline__ int fresh_tid(int wave_s) { int l; asm volatile("v_mbcnt_lo_u32_b32 %0, -1, 0\n\tv_mbcnt_hi_u32_b32 %0, -1, %0" : "=v"(l)); return wave_s * 64 + l; }
namespace pg8 {
#define PG8_LAS __attribute__((address_space(3)))
typedef unsigned short bf16_t;
typedef short bf16x8 __attribute__((ext_vector_type(8)));
typedef float f32x4 __attribute__((ext_vector_type(4)));
typedef unsigned u32x4 __attribute__((ext_vector_type(4)));
constexpr int BM = 256, BK = 64, HALF = 128, HTB = HALF * BK * 2  , STAGE_BYTES = 8 * HTB, NXCD = 8, WGM = 8;

__host__ __device__ __forceinline__ int lds_byte(int r, int c) { const int st = (r >> 4) * 2 + (c >> 5), rr = r & 15, cc = c & 31, ob = rr * 64 + cc * 2; return st * 1024 + (ob ^ (((ob >> 9) & 1) << 5)); }
__host__ __device__ __forceinline__ void stage_rc(int b, int& R, int& C) { const int st = b / 1024, sb = b % 1024, swz = sb ^ (((sb >> 9) & 1) << 5); R = (st >> 1) * 16 + swz / 64; C = (st & 1) * 32 + (swz % 64) / 2; }
__host__ __device__ __forceinline__ int perm32(int rho) { const int n = rho >> 4, i = rho & 15; return 8 * (i >> 2) + 4 * n + (i & 3); }

struct Unit { int pm, pn; };
struct Gemm { const bf16_t* A; const bf16_t* Bt; int M, N, K; };

struct StaticOrder {
    int nM, nN, nwg, G, c;
    __host__ __device__ void init(int M, int N, int G_, int c_) { nM = M / BM; nN = N / BM; nwg = nM * nN; G = G_; c = c_; }
    __host__ __device__ bool next(int i, Unit& u) const {
        const long L = (long)i * G + c; if (L >= nwg) return false;
        int wgid = (int)L; { const int q = nwg / NXCD, r = nwg % NXCD, xcd = wgid % NXCD, off = wgid / NXCD; wgid = (xcd < r ? xcd * (q + 1) : r * (q + 1) + (xcd - r) * q) + off; }
        const int nig = WGM * nN, gid = wgid / nig, fm = gid * WGM, gsz = (nM - fm) < WGM ? (nM - fm) : WGM;
        u.pm = fm + ((wgid % nig) % gsz); u.pn = (wgid % nig) / gsz; return true;
    }
    __device__ __forceinline__ void a_ready(const Unit&) const {}
    __device__ __forceinline__ void done(const Unit&) const {}
};

__device__ __forceinline__ unsigned cvt_pk_bf16(float lo, float hi) { unsigned r; asm volatile("v_cvt_pk_bf16_f32 %0, %1, %2" : "=v"(r) : "v"(lo), "v"(hi)); return r; }
typedef float f32x2 __attribute__((ext_vector_type(2)));
template <class Epi, class Sched, bool ALIGN_EPI = false, bool SP2 = false>
__device__ __forceinline__ void gemm_phase(PG8_LAS unsigned char* lds, const Gemm g, const Sched& S, const Epi& E, int wave_s) {
    const int tid = fresh_tid(wave_s), wid = wave_s, lane = tid & 63, wr = wid >> 2, wc = wid & 3, fr = lane & 15, fq = lane >> 4;
    const int K = g.K, nt = K / BK;
    unsigned voffA[2], voffB[2];
#pragma unroll
    for (int i = 0; i < 2; ++i) { int R, C; stage_rc(tid * 16 + i * 8192, R, C); const int Rb = Epi::PERM ? ((R & ~31) + perm32(R & 31)) : R;
        voffA[i] = (unsigned)(R * K + C) * 2u; voffB[i] = (unsigned)(Rb * K + C) * 2u; }
    const size_t kstep = (size_t)(BK * 2);
    const size_t hstep = (size_t)HALF * K * 2;
    const size_t tstep = 2 * hstep;
    const unsigned ldsw = (unsigned)wid * 1024u;
    const int aoff = lds_byte(wr * 64 + fr, fq * 8), boff = lds_byte(wc * 32 + fr, fq * 8);
#define PG8_SA(b, h) (((b) * 2 + (h)) * HTB)
#define PG8_SB(b, h) ((4 + (b) * 2 + (h)) * HTB)
#define PG8_STAGE(bufoff, gbase, voff) do { _Pragma("unroll") for (int _i = 0; _i < 2; ++_i) \
        __builtin_amdgcn_global_load_lds((const unsigned*)((const char*)(gbase) + (voff)[_i]), (PG8_LAS unsigned*)(lds + (bufoff) + ldsw + _i * 8192), 16, 0, 0); } while (0)
#define PG8_LDA(dst, b, h) do { _Pragma("unroll") for (int m = 0; m < 4; ++m) _Pragma("unroll") for (int k = 0; k < 2; ++k) dst[m][k] = *(const PG8_LAS bf16x8*)(lds + PG8_SA(b, h) + aoff + m * 2048 + k * 1024); } while (0)
#define PG8_LDB(dst, b, h) do { _Pragma("unroll") for (int n = 0; n < 2; ++n) _Pragma("unroll") for (int k = 0; k < 2; ++k) dst[n][k] = *(const PG8_LAS bf16x8*)(lds + PG8_SB(b, h) + boff + n * 2048 + k * 1024); } while (0)
#define PG8_MMA(ai, bj, At, Bt) do { __builtin_amdgcn_s_setprio(1); _Pragma("unroll") for (int m = 0; m < 4; ++m) _Pragma("unroll") for (int n = 0; n < 2; ++n) _Pragma("unroll") for (int k = 0; k < 2; ++k) \
        acc[ai][bj][m][n] = __builtin_amdgcn_mfma_f32_16x16x32_bf16(Bt[n][k], At[m][k], acc[ai][bj][m][n], 0, 0, 0); __builtin_amdgcn_s_setprio(0); } while (0)
#define PG8_WAIT_V(n) asm volatile("s_waitcnt vmcnt(" #n ")" ::: "memory")
#define PG8_WAIT_L(n) asm volatile("s_waitcnt lgkmcnt(" #n ")" ::: "memory")
#define PG8_BAR __builtin_amdgcn_s_barrier()
#define PG8_SCHED __builtin_amdgcn_sched_barrier(0)
    Unit cur, nxt; int ui = 0;
    if (!S.next(0, cur)) return;
    f32x4 acc[2][2][4][2];
#pragma unroll
    for (int a = 0; a < 2; ++a)
#pragma unroll
        for (int b = 0; b < 2; ++b)
#pragma unroll
            for (int m = 0; m < 4; ++m)
#pragma unroll
                for (int n = 0; n < 2; ++n) acc[a][b][m][n] = (f32x4){0.f, 0.f, 0.f, 0.f};
    bf16x8 At[4][2], B0[2][2], B1[2][2];
    const char* cA = (const char*)g.A + (size_t)cur.pm * tstep; const char* cB = (const char*)g.Bt + (size_t)cur.pn * tstep;
    S.a_ready(cur);
    if constexpr (SP2) {
        PG8_STAGE(PG8_SB(0, 0), cB, voffB); PG8_STAGE(PG8_SB(0, 1), cB + hstep, voffB); PG8_STAGE(PG8_SA(0, 0), cA, voffA); PG8_STAGE(PG8_SA(0, 1), cA + hstep, voffA);
        if (wr == 1) PG8_BAR;
        PG8_WAIT_V(2); PG8_BAR;
        PG8_STAGE(PG8_SB(1, 0), cB + kstep, voffB); PG8_STAGE(PG8_SA(1, 0), cA + kstep, voffA); PG8_STAGE(PG8_SB(1, 1), cB + hstep + kstep, voffB);
        PG8_WAIT_V(6); PG8_BAR;
    } else {
        PG8_STAGE(PG8_SB(0, 0), cB, voffB); PG8_STAGE(PG8_SA(0, 0), cA, voffA); PG8_STAGE(PG8_SB(0, 1), cB + hstep, voffB); PG8_STAGE(PG8_SA(0, 1), cA + hstep, voffA);
        if (wr == 1) PG8_BAR;
        PG8_WAIT_V(4); PG8_BAR;
        PG8_STAGE(PG8_SB(1, 0), cB + kstep, voffB); PG8_STAGE(PG8_SA(1, 0), cA + kstep, voffA); PG8_STAGE(PG8_SB(1, 1), cB + hstep + kstep, voffB);
        PG8_WAIT_V(6); PG8_BAR;
    }
    for (;;) {
        const bool has_next = S.next(ui + 1, nxt);
        const char* nA = has_next ? (const char*)g.A + (size_t)nxt.pm * tstep : cA; const char* nB = has_next ? (const char*)g.Bt + (size_t)nxt.pn * tstep : cB;
        for (int t = 0; t < nt; t += 2) {
            const bool last = (t == nt - 2);
            const char* a1 = cA + (size_t)(t + 1) * kstep;
            const char* a2 = last ? nA : cA + (size_t)(t + 2) * kstep; const char* b2 = last ? nB : cB + (size_t)(t + 2) * kstep;
            const char* a3 = a2 + kstep; const char* b3 = b2 + kstep;
            if (last && has_next) S.a_ready(nxt);
            if constexpr (SP2) {
            PG8_LDB(B0, 0, 0); PG8_LDB(B1, 0, 1); PG8_SCHED; PG8_LDA(At, 0, 0); PG8_STAGE(PG8_SA(1, 1), a1 + hstep, voffA);
            PG8_WAIT_V(8); PG8_WAIT_L(0); PG8_BAR; PG8_MMA(0, 0, At, B0); PG8_MMA(0, 1, At, B1); PG8_BAR; PG8_SCHED;
            PG8_LDA(At, 0, 1); PG8_STAGE(PG8_SB(0, 0), b2, voffB); PG8_STAGE(PG8_SB(0, 1), b2 + hstep, voffB); PG8_STAGE(PG8_SA(0, 0), a2, voffA);
            PG8_WAIT_V(8); PG8_WAIT_L(0); PG8_BAR; PG8_MMA(1, 0, At, B0); PG8_MMA(1, 1, At, B1); PG8_BAR; PG8_SCHED;
            PG8_LDB(B0, 1, 0); PG8_LDB(B1, 1, 1); PG8_SCHED; PG8_LDA(At, 1, 0); PG8_STAGE(PG8_SA(0, 1), a2 + hstep, voffA);
            PG8_WAIT_V(8); PG8_WAIT_L(0); PG8_BAR; PG8_MMA(0, 0, At, B0); PG8_MMA(0, 1, At, B1); PG8_BAR; PG8_SCHED;
            PG8_LDA(At, 1, 1); PG8_STAGE(PG8_SB(1, 0), b3, voffB); PG8_STAGE(PG8_SB(1, 1), b3 + hstep, voffB); PG8_STAGE(PG8_SA(1, 0), a3, voffA);
            PG8_WAIT_V(8); PG8_WAIT_L(0); PG8_BAR; PG8_MMA(1, 0, At, B0); PG8_MMA(1, 1, At, B1); PG8_BAR; PG8_SCHED;
            } else {
            PG8_LDB(B0, 0, 0); PG8_SCHED; PG8_LDA(At, 0, 0); PG8_STAGE(PG8_SA(1, 1), a1 + hstep, voffA);
            PG8_WAIT_L(8); PG8_BAR; PG8_WAIT_L(0); PG8_MMA(0, 0, At, B0); PG8_BAR; PG8_SCHED;
            PG8_LDB(B1, 0, 1); PG8_STAGE(PG8_SB(0, 0), b2, voffB);
            PG8_BAR; PG8_WAIT_L(0); PG8_MMA(0, 1, At, B1); PG8_BAR;
            PG8_LDA(At, 0, 1); PG8_STAGE(PG8_SA(0, 0), a2, voffA);
            PG8_BAR; PG8_WAIT_L(0); PG8_MMA(1, 0, At, B0); PG8_BAR; PG8_SCHED;
            PG8_STAGE(PG8_SB(0, 1), b2 + hstep, voffB);
            PG8_WAIT_V(6); PG8_BAR; PG8_MMA(1, 1, At, B1); PG8_BAR;
            PG8_LDB(B0, 1, 0); PG8_SCHED; PG8_LDA(At, 1, 0); PG8_STAGE(PG8_SA(0, 1), a2 + hstep, voffA);
            PG8_WAIT_L(8); PG8_BAR; PG8_WAIT_L(0); PG8_MMA(0, 0, At, B0); PG8_BAR; PG8_SCHED;
            PG8_LDB(B1, 1, 1); PG8_STAGE(PG8_SB(1, 0), b3, voffB);
            PG8_BAR; PG8_WAIT_L(0); PG8_MMA(0, 1, At, B1); PG8_BAR;
            PG8_LDA(At, 1, 1); PG8_STAGE(PG8_SA(1, 0), a3, voffA);
            PG8_BAR; PG8_WAIT_L(0); PG8_MMA(1, 0, At, B0); PG8_BAR; PG8_SCHED;
            PG8_STAGE(PG8_SB(1, 1), b3 + hstep, voffB);
            PG8_WAIT_V(6); PG8_BAR; PG8_MMA(1, 1, At, B1); PG8_BAR;
            }
        }
        if constexpr (ALIGN_EPI) { if (wr == 0) PG8_BAR; }
        if constexpr (!Epi::AFTER_DRAIN) { E(acc, cur, wr, wc, fr, fq); S.done(cur); }
        if (!has_next) break;
#pragma unroll
        for (int a = 0; a < 2; ++a)
#pragma unroll
            for (int b = 0; b < 2; ++b)
#pragma unroll
                for (int m = 0; m < 4; ++m)
#pragma unroll
                    for (int n = 0; n < 2; ++n) acc[a][b][m][n] = (f32x4){0.f, 0.f, 0.f, 0.f};
        cur = nxt; cA = nA; cB = nB; ++ui;
        if constexpr (ALIGN_EPI) { if (wr == 1) PG8_BAR; }
    }
    PG8_WAIT_V(0);
    if constexpr (!ALIGN_EPI) { if (wr == 0) PG8_BAR; }
    PG8_BAR;
    if constexpr (Epi::AFTER_DRAIN) { E.fused(acc, cur, wr, wc, fr, fq, lds, wid, lane); S.done(cur); }
#undef PG8_SA
#undef PG8_SB
#undef PG8_STAGE
#undef PG8_LDA
#undef PG8_LDB
#undef PG8_MMA
#undef PG8_WAIT_V
#undef PG8_WAIT_L
#undef PG8_BAR
#undef PG8_SCHED
}
}
#include <hip/hip_bf16.h>
namespace attn_body {
using bf16=__hip_bfloat16;
using bf16x8=__attribute__((ext_vector_type(8)))short;
using s16x4=__attribute__((ext_vector_type(4)))short;
using f32x16=__attribute__((ext_vector_type(16)))float;
using u32x4=__attribute__((ext_vector_type(4)))unsigned;
constexpr int BATCH=4,NHEAD=32,SEQ=8192,D=64,QP=1024,KP=64,VP=64,OP=2048;
constexpr int NW=8,QBLK=32,QB=QBLK*NW,KVBLK=64,NQB=SEQ/QB;
constexpr int ATTN_UNIT_ROWS=QB;
__device__ __forceinline__ int crow(int r,int hi){return (r&3)+8*(r>>2)+4*hi;}
#define SBAR() __builtin_amdgcn_sched_barrier(0)
__device__ __forceinline__ void cmask(f32x16&p0,f32x16&p1,int jb,int qrel,int hi){
  const float NEG=-INFINITY; int kb=64*jb+4*hi;
  #pragma unroll
  for(int r=0;r<16;++r){int kv=kb+(r&3)+8*(r>>2); if(kv>qrel)p0[r]=NEG; if(kv+32>qrel)p1[r]=NEG;}
}

__device__ __forceinline__ void addbias(f32x16&p0,f32x16&p1,const __attribute__((address_space(3))) float* tb){
  #pragma unroll
  for(int r=0;r<16;++r){ p0[r]+=tb[-((r&3)+8*(r>>2))]; p1[r]+=tb[-((r&3)+8*(r>>2))-32]; }
}
constexpr int NSLOT=3, SLOTB=8192;
constexpr int LDS_K=0, LDS_V=NSLOT*SLOTB, LDS_WS=2*NSLOT*SLOTB, LDS_OST=LDS_WS+NW*64*4, LDS_BYTES=LDS_OST+NW*4096;
constexpr float C2=0.125f*1.4426950408889634f;
__device__ __forceinline__ void glds16(const void*gsrc,unsigned lds_dst){unsigned keep;
  asm volatile("s_mov_b32 %0, m0\n\ts_mov_b32 m0, %2\n\ts_nop 0\n\tglobal_load_lds_dwordx4 %1, off\n\ts_mov_b32 m0, %0":"=&s"(keep):"v"(gsrc),"s"(lds_dst):"memory");}
__device__ __forceinline__ float max3f(float a,float b,float c){float r;asm("v_max3_f32 %0, %1, %2, %3":"=v"(r):"v"(a),"v"(b),"v"(c));return r;}
__device__ __forceinline__ float max2f(float a,float b){float r;asm("v_max_f32_e32 %0, %1, %2":"=v"(r):"v"(a),"v"(b));return r;}
__device__ __forceinline__ float fadd_s(float a,float b){float r;asm("v_add_f32_e32 %0, %1, %2":"=v"(r):"v"(a),"v"(b));return r;}
__device__ __forceinline__ float fsub_s(float a,float b){float r;asm("v_sub_f32_e32 %0, %1, %2":"=v"(r):"v"(a),"v"(b));return r;}
typedef float f32x2_t __attribute__((ext_vector_type(2))); typedef __bf16 bf16x2_t __attribute__((ext_vector_type(2)));
__device__ __forceinline__ unsigned cvtpk_s(float lo,float hi){f32x2_t v={lo,hi};bf16x2_t b=__builtin_convertvector(v,bf16x2_t);return __builtin_bit_cast(unsigned,b);}
#define WAIT_BAR(N) asm volatile("s_waitcnt vmcnt(" #N ") lgkmcnt(0)\n\ts_barrier":::"memory")

__device__ __forceinline__ void qkt(f32x16&p0,f32x16&p1,const char*Kslot,const bf16x8*qr,const f32x16&negm,int r32,int hi){
  const char*kb=Kslot+hi*1024+r32*16;
  #pragma unroll
  for(int d0=0;d0<4;++d0){
    const bf16x8 b0=*reinterpret_cast<const bf16x8*>(kb+d0*2048);
    const bf16x8 b1=*reinterpret_cast<const bf16x8*>(kb+d0*2048+512);
    if(d0==0){p0=__builtin_amdgcn_mfma_f32_32x32x16_bf16(b0,qr[0],negm,0,0,0);p1=__builtin_amdgcn_mfma_f32_32x32x16_bf16(b1,qr[0],negm,0,0,0);}
    else{p0=__builtin_amdgcn_mfma_f32_32x32x16_bf16(b0,qr[d0],p0,0,0,0);p1=__builtin_amdgcn_mfma_f32_32x32x16_bf16(b1,qr[d0],p1,0,0,0);}}
}
typedef __attribute__((address_space(3))) const char* lds_cptr;
typedef short v4i16_t __attribute__((ext_vector_type(4)));
__device__ __forceinline__ void kload8(bf16x8*kf,lds_cptr kp){
  kf[0]=*(const __attribute__((address_space(3))) bf16x8*)(kp);      kf[1]=*(const __attribute__((address_space(3))) bf16x8*)(kp+512);
  kf[2]=*(const __attribute__((address_space(3))) bf16x8*)(kp+2048); kf[3]=*(const __attribute__((address_space(3))) bf16x8*)(kp+2560);
  kf[4]=*(const __attribute__((address_space(3))) bf16x8*)(kp+4096); kf[5]=*(const __attribute__((address_space(3))) bf16x8*)(kp+4608);
  kf[6]=*(const __attribute__((address_space(3))) bf16x8*)(kp+6144); kf[7]=*(const __attribute__((address_space(3))) bf16x8*)(kp+6656);
}
__device__ __forceinline__ void kload2(bf16x8*kf,lds_cptr kp,int j){ kf[2*j]=*(const __attribute__((address_space(3))) bf16x8*)(kp+j*2048); kf[2*j+1]=*(const __attribute__((address_space(3))) bf16x8*)(kp+j*2048+512); }
__device__ __forceinline__ s16x4 vtr(lds_cptr p){ return __builtin_bit_cast(s16x4,__builtin_amdgcn_ds_read_tr16_b64_v4i16((__attribute__((address_space(3))) v4i16_t*)p)); }
__device__ __forceinline__ float rowmax(const f32x16&p0,const f32x16&p1){
  float a=max3f(p0[0],p0[1],p1[0]),b=max3f(p0[2],p0[3],p1[1]);a=max3f(a,p1[2],p1[3]);
  #pragma unroll
  for(int r=4;r<16;r+=4){a=max3f(a,p0[r],p0[r+1]);b=max3f(b,p0[r+2],p0[r+3]);a=max3f(a,p1[r],p1[r+1]);b=max3f(b,p1[r+2],p1[r+3]);}
  float m=max2f(a,b); asm volatile("s_nop 7":"+v"(m));
  auto rr=__builtin_amdgcn_permlane32_swap(__float_as_uint(m),__float_as_uint(m),false,false);
  return max2f(__uint_as_float(rr[0]),__uint_as_float(rr[1]));
}
__device__ __forceinline__ void pv(f32x16*o,int vb,bf16x8 pa0,bf16x8 pa1,bf16x8 pa2,bf16x8 pa3){
  #pragma unroll
  for(int d0=0;d0<2;++d0){s16x4 lo[4],hi[4];
    #pragma unroll
    for(int ks=0;ks<4;++ks){
      asm volatile("ds_read_b64_tr_b16 %0,%1 offset:%c2":"=&v"(lo[ks]):"v"(vb),"i"(d0*4096+ks*1024):"memory");
      asm volatile("ds_read_b64_tr_b16 %0,%1 offset:%c2":"=&v"(hi[ks]):"v"(vb),"i"(d0*4096+ks*1024+512):"memory");}
    asm volatile("s_waitcnt lgkmcnt(0)":::"memory");SBAR();
    #define PK(k) (bf16x8){lo[k][0],lo[k][1],lo[k][2],lo[k][3],hi[k][0],hi[k][1],hi[k][2],hi[k][3]}
    o[d0]=__builtin_amdgcn_mfma_f32_32x32x16_bf16(pa0,PK(0),o[d0],0,0,0);
    o[d0]=__builtin_amdgcn_mfma_f32_32x32x16_bf16(pa1,PK(1),o[d0],0,0,0);
    o[d0]=__builtin_amdgcn_mfma_f32_32x32x16_bf16(pa2,PK(2),o[d0],0,0,0);
    o[d0]=__builtin_amdgcn_mfma_f32_32x32x16_bf16(pa3,PK(3),o[d0],0,0,0);
    #undef PK
  }
}

#ifndef ATTN_STORE16
#define ATTN_STORE16(p,v) (*(u32x4*)(p)=(v))
#endif
template<int THRL> __device__ __forceinline__ void attn_unit(int b,int vh,int qb,const bf16*Q,const bf16*__restrict__ K,const bf16*__restrict__ V,bf16*O,const float*btab,char*shm,int wave_s){
  const int h=vh>>2,jm=(vh>>1)&1,cv=vh&1;
  const int tid=fresh_tid(wave_s),lane=tid&63,r32=lane&31,hi=lane>>5; const int wid=wave_s;
  const long rowbase=(long)b*SEQ; const int q0=qb*QB;
  const bf16*Qw=Q+(rowbase+q0+wid*QBLK)*QP+jm*512+h*64;
  const bf16*Kh=K+(long)((jm*BATCH+b)*8+h)*SEQ*64,*Vh=V+(long)((b*8+h)*2+cv)*SEQ*64;
  const unsigned lds0=(unsigned)(uintptr_t)shm;
  float*wsf=(float*)(shm+LDS_WS)+wid*64;
  const bf16*ksrc=Kh+(long)lane*KP+wid*8;
  const bf16*vsrc=Vh+(long)(16*(wid&3)+(lane>>2))*VP+(wid>>2)*32+(lane&3)*8;
  const unsigned kdst=lds0+LDS_K+wid*1024, vdst=lds0+LDS_V+wid*1024;
  #define DMA_K(t,slot) glds16(ksrc+(long)(t)*KVBLK*KP,(unsigned)__builtin_amdgcn_readfirstlane(kdst+(slot)))
  #define DMA_V(t,slot) glds16(vsrc+(long)(t)*KVBLK*VP,(unsigned)__builtin_amdgcn_readfirstlane(vdst+(slot)))
  const int vb0=(int)(lds0+LDS_V)+((lane>>4)&1)*32+(lane&3)*8+(4*hi+((lane&15)>>2))*64;
  const char*Kbase=shm+LDS_K; bf16x8 kf[8];
  const lds_cptr shm3=(lds_cptr)shm; const lds_cptr kp0=shm3+LDS_K+hi*1024+r32*16; const lds_cptr vp0=shm3+LDS_V+((lane>>4)&1)*32+(lane&3)*8+(4*hi+((lane&15)>>2))*64;
  const __attribute__((address_space(3))) float* tabL=(const __attribute__((address_space(3))) float*)(shm3+LDS_BYTES);
  { __attribute__((address_space(3))) float* tw=(__attribute__((address_space(3))) float*)(shm3+LDS_BYTES); const int d_=tid-256; tw[tid]=(d_>=0&&d_<128)?btab[h*128+d_]:0.f; if(tid<256)tw[512+tid]=0.f; }
  const int NT=(q0+QB)/KVBLK;
  DMA_K(0,0);DMA_V(0,0);DMA_K(1,SLOTB);
  bf16x8 qr[4];
  #pragma unroll
  for(int d0=0;d0<4;++d0)qr[d0]=*reinterpret_cast<const bf16x8*>(&Qw[(long)r32*QP+d0*16+hi*8]);
  float mhat=0.f,l_reg=0.f;f32x16 o[2];o[0]=f32x16{};o[1]=f32x16{};f32x16 negm=f32x16{};asm volatile("":"+v"(negm));
  const int qrel=wid*QBLK+r32;
  #define CMASK(P0,P1,t) do{ if((t)>=NT-6+(wid>>1)&&(t)<=NT-4+(wid>>1)) addbias(P0,P1,tabL+(256+q0+qrel-64*(t)-4*hi)); int jb_=(t)-(NT-4); if(jb_>=0)cmask(P0,P1,jb_,qrel,hi);}while(0)
  bool resc=false;
  #define START(P0,P1) do{ const float rm=rowmax(P0,P1); resc=false; \
    { const float dl=rm; mhat=fadd_s(mhat,dl); \
      _Pragma("unroll") for(int r=0;r<16;++r){P0[r]=fsub_s(P0[r],dl);P1[r]=fsub_s(P1[r],dl);} \
      _Pragma("unroll") for(int r=0;r<16;++r)negm[r]=-mhat; asm volatile("":"+v"(negm)); } \
    _Pragma("unroll") for(int r=0;r<16;++r)P0[r]=__builtin_amdgcn_exp2f(P0[r]); }while(0)
  #define RESC() do{ if(resc){ asm volatile("s_waitcnt lgkmcnt(0)":::"memory"); \
      _Pragma("unroll") for(int d_=0;d_<2;++d_) _Pragma("unroll") for(int r=0;r<16;++r)o[d_][r]*=wsf[crow(r,hi)]; } }while(0)
  f32x16 pA0,pA1,pB0,pB1;
  int sl_prev=0,sl_cur=0,sl_next=SLOTB;
  #define ROT() do{sl_prev=sl_cur;sl_cur=sl_next;sl_next=(sl_next==(NSLOT-1)*SLOTB)?0:sl_next+SLOTB;}while(0)
  DMA_K(2,2*SLOTB);
  WAIT_BAR(3);
  qkt(pA0,pA1,Kbase,qr,negm,r32,hi);asm volatile("s_nop 15\n\ts_nop 7":"+v"(pA0),"+v"(pA1));CMASK(pA0,pA1,0);
  START(pA0,pA1);
  _Pragma("unroll") for(int r=0;r<16;++r)pA1[r]=__builtin_amdgcn_exp2f(pA1[r]);
  WAIT_BAR(0);
  DMA_K(3,0);DMA_V(1,SLOTB);
  ROT();
  kload8(kf,kp0+sl_cur);
  WAIT_BAR(2);
  s16x4 vlo[8],vhi[8]; u32x4 pw0,pw1,pw2,pw3;
  #define PKW(P,B) cvtpk_s(P[B],P[B+1])
  #define PAF(k) __builtin_bit_cast(bf16x8,pw##k)
  #define VFR(i) (bf16x8){vlo[i][0],vlo[i][1],vlo[i][2],vlo[i][3],vhi[i][0],vhi[i][1],vhi[i][2],vhi[i][3]}
  #define PIN(x) asm volatile("":"+v"(x))
  #define MX3(a,b,c) __builtin_fmaxf(__builtin_fmaxf((a),(b)),(c))
  #define GAPA(MF,A0,A1,A2,A3,W0,W1,PW) do{ MF; sacc+=A0; sacc+=A1; sacc+=A2; sacc+=A3; PIN(sacc); W0; W1; PIN(PW); SBAR(); }while(0)
  #define EX(v) __builtin_amdgcn_exp2f(v)
  #define GAPB(MF,X,B) do{ MF; X[B]=EX(X[B]); X[B+1]=EX(X[B+1]); X[B+2]=EX(X[B+2]); X[B+3]=EX(X[B+3]); PIN(X); SBAR(); }while(0)
  #define VRD(i) do{ vlo[i]=vtr(vp_+(((i)>>2)*4096+((i)&3)*1024)); vhi[i]=vtr(vp_+(((i)>>2)*4096+((i)&3)*1024+512)); }while(0)
  #define KRD(G,j) do{ if(G){ kload2(kf,kp0+sl_next,j); SBAR(); } }while(0)
  #define STEP(C0,C1,P0,P1,t,GK,GV,GL) do{ SBAR(); \
    const lds_cptr vp_=vp0+sl_prev; \
    VRD(0); SBAR(); float sacc=(P0[0]+P0[1]); \
    GAPA(C0=__builtin_amdgcn_mfma_f32_32x32x16_bf16(kf[0],qr[0],negm,0,0,0), P0[2],P0[3],P0[4],P0[5],     pw0[0]=PKW(P0,0), pw0[1]=PKW(P0,2), pw0); \
    VRD(4); SBAR(); GAPA(C1=__builtin_amdgcn_mfma_f32_32x32x16_bf16(kf[1],qr[0],negm,0,0,0), P0[6],P0[7],P0[8],P0[9],     pw0[2]=PKW(P0,4), pw0[3]=PKW(P0,6), pw0); \
    VRD(1); SBAR(); GAPA(C0=__builtin_amdgcn_mfma_f32_32x32x16_bf16(kf[2],qr[1],C0,0,0,0),   P0[10],P0[11],P0[12],P0[13], pw1[0]=PKW(P0,8), pw1[1]=PKW(P0,10), pw1); \
    VRD(5); SBAR(); GAPA(C1=__builtin_amdgcn_mfma_f32_32x32x16_bf16(kf[3],qr[1],C1,0,0,0),   P0[14],P0[15],P1[0],P1[1],   pw1[2]=PKW(P0,12),pw1[3]=PKW(P0,14), pw1); \
    VRD(2); SBAR(); GAPA(C0=__builtin_amdgcn_mfma_f32_32x32x16_bf16(kf[4],qr[2],C0,0,0,0),   P1[2],P1[3],P1[4],P1[5],     pw2[0]=PKW(P1,0), pw2[1]=PKW(P1,2), pw2); \
    VRD(6); SBAR(); GAPA(C1=__builtin_amdgcn_mfma_f32_32x32x16_bf16(kf[5],qr[2],C1,0,0,0),   P1[6],P1[7],P1[8],P1[9],     pw2[2]=PKW(P1,4), pw2[3]=PKW(P1,6), pw2); \
    VRD(3); SBAR(); GAPA(C0=__builtin_amdgcn_mfma_f32_32x32x16_bf16(kf[6],qr[3],C0,0,0,0),   P1[10],P1[11],P1[12],P1[13], pw3[0]=PKW(P1,8), pw3[1]=PKW(P1,10), pw3); \
    VRD(7); SBAR(); GAPA(C1=__builtin_amdgcn_mfma_f32_32x32x16_bf16(kf[7],qr[3],C1,0,0,0),   P1[14],P1[15],0.f,0.f,       pw3[2]=PKW(P1,12),pw3[3]=PKW(P1,14), pw3); \
    l_reg+=sacc; \
    if(GK){DMA_K((t)+3,sl_cur);} if(GV){DMA_V((t)+1,sl_next);} \
    CMASK(C0,C1,t); \
    { float a=MX3(C0[0],C0[1],C1[0]),b=MX3(C0[2],C0[3],C1[1]); a=MX3(a,C1[2],C1[3]); \
      _Pragma("unroll") for(int r=4;r<16;r+=4){a=MX3(a,C0[r],C0[r+1]);b=MX3(b,C0[r+2],C0[r+3]);a=MX3(a,C1[r],C1[r+1]);b=MX3(b,C1[r+2],C1[r+3]);} \
      float rm=__builtin_fmaxf(a,b); asm volatile("s_nop 7":"+v"(rm)); { auto rr=__builtin_amdgcn_permlane32_swap(__float_as_uint(rm),__float_as_uint(rm),false,false); rm=__builtin_fmaxf(__uint_as_float(rr[0]),__uint_as_float(rr[1])); } \
      resc=false; \
      if(__builtin_expect(__any(rm>(float)THRL),0)){ const float dl=__builtin_fmaxf(rm,0.f); mhat+=dl; \
        _Pragma("unroll") for(int r=0;r<16;++r){C0[r]-=dl;C1[r]-=dl;} \
        _Pragma("unroll") for(int r=0;r<16;++r)negm[r]=-mhat; asm volatile("":"+v"(negm)); \
        const float f=__builtin_amdgcn_exp2f(-dl); l_reg*=f; if(hi==0)wsf[r32]=f; resc=true; } } \
    SBAR(); \
    GAPB(o[0]=__builtin_amdgcn_mfma_f32_32x32x16_bf16(PAF(0),VFR(0),o[0],0,0,0), C0,0); \
    GAPB(o[1]=__builtin_amdgcn_mfma_f32_32x32x16_bf16(PAF(0),VFR(4),o[1],0,0,0), C0,4); \
    KRD(GL,0); GAPB(o[0]=__builtin_amdgcn_mfma_f32_32x32x16_bf16(PAF(1),VFR(1),o[0],0,0,0), C0,8); \
    KRD(GL,1); GAPB(o[1]=__builtin_amdgcn_mfma_f32_32x32x16_bf16(PAF(1),VFR(5),o[1],0,0,0), C0,12); \
    KRD(GL,2); GAPB(o[0]=__builtin_amdgcn_mfma_f32_32x32x16_bf16(PAF(2),VFR(2),o[0],0,0,0), C1,0); \
    KRD(GL,3); GAPB(o[1]=__builtin_amdgcn_mfma_f32_32x32x16_bf16(PAF(2),VFR(6),o[1],0,0,0), C1,4); \
    GAPB(o[0]=__builtin_amdgcn_mfma_f32_32x32x16_bf16(PAF(3),VFR(3),o[0],0,0,0), C1,8); \
    GAPB(o[1]=__builtin_amdgcn_mfma_f32_32x32x16_bf16(PAF(3),VFR(7),o[1],0,0,0), C1,12); \
    }while(0)
  int t=1;
  #undef CMASK
  #define CMASK(P0,P1,t) do{}while(0)
  for(;t+7<NT;t+=2){
    STEP(pB0,pB1,pA0,pA1,t,true,true,true);     WAIT_BAR(2); RESC(); ROT();
    STEP(pA0,pA1,pB0,pB1,t+1,true,true,true);   WAIT_BAR(2); RESC(); ROT();
  }
  #undef CMASK
  #define CMASK(P0,P1,t) do{ if((t)>=NT-6+(wid>>1)&&(t)<=NT-4+(wid>>1)) addbias(P0,P1,tabL+(256+q0+qrel-64*(t)-4*hi)); int jb_=(t)-(NT-4); if(jb_>=0)cmask(P0,P1,jb_,qrel,hi);}while(0)
  #define ENDW(tt) do{ if((tt)+3<NT){WAIT_BAR(2);} else if((tt)+2<NT){WAIT_BAR(1);} else {WAIT_BAR(0);} }while(0)
  for(;t+1<NT;t+=2){
    STEP(pB0,pB1,pA0,pA1,t,(t+3<NT),(t+1<NT),(t+1<NT));       ENDW(t);   RESC(); ROT();
    STEP(pA0,pA1,pB0,pB1,t+1,(t+4<NT),(t+2<NT),(t+2<NT));     ENDW(t+1); RESC(); ROT();
  }
  STEP(pB0,pB1,pA0,pA1,NT-1,false,false,false); RESC();
  { float sacc=pB0[0]+pB0[1]; _Pragma("unroll") for(int r=2;r<16;++r)sacc+=pB0[r]; _Pragma("unroll") for(int r=0;r<16;++r)sacc+=pB1[r]; l_reg+=sacc;
    pw0=(u32x4){PKW(pB0,0),PKW(pB0,2),PKW(pB0,4),PKW(pB0,6)};pw1=(u32x4){PKW(pB0,8),PKW(pB0,10),PKW(pB0,12),PKW(pB0,14)};pw2=(u32x4){PKW(pB1,0),PKW(pB1,2),PKW(pB1,4),PKW(pB1,6)};pw3=(u32x4){PKW(pB1,8),PKW(pB1,10),PKW(pB1,12),PKW(pB1,14)};
    SBAR(); pv(o,vb0+sl_cur,PAF(0),PAF(1),PAF(2),PAF(3)); }
  #undef PKW
  #undef PAF
  #undef VFR
  #undef PIN
  #undef MX3
  #undef GAPA
  #undef GAPB
  #undef EX
  #undef VRD
  #undef KRD
  #undef STEP
  #undef ENDW
  asm volatile("s_nop 7":"+v"(l_reg)); {auto rr=__builtin_amdgcn_permlane32_swap(__float_as_uint(l_reg),__float_as_uint(l_reg),false,false);l_reg=__uint_as_float(rr[0])+__uint_as_float(rr[1]);}
  if(hi==0)wsf[32+r32]=l_reg;asm volatile("s_waitcnt lgkmcnt(0)":::"memory");
  float rli[16];
  #pragma unroll
  for(int r=0;r<16;++r)rli[r]=__builtin_amdgcn_rcpf(wsf[32+crow(r,hi)]);
  bf16*Ow=O+(rowbase+q0+wid*QBLK)*OP+jm*1024+h*128+cv*64;
  { bf16*stg=(bf16*)(shm+LDS_OST)+wid*2048;
    #pragma unroll
    for(int r=0;r<16;++r){const int orow=crow(r,hi);
      #pragma unroll
      for(int d0=0;d0<2;++d0)stg[orow*64+d0*32+r32]=__float2bfloat16(o[d0][r]*rli[r]);}
    asm volatile("s_waitcnt lgkmcnt(0)":::"memory");
    #pragma unroll
    for(int i=0;i<4;++i){const int row=i*8+(lane>>3),ch=lane&7; const u32x4 v=*(const u32x4*)(stg+row*64+ch*8); ATTN_STORE16(Ow+(long)row*OP+ch*8,v);} }
  asm volatile("s_waitcnt lgkmcnt(0)\n\ts_barrier":::"memory");
  #undef DMA_K
  #undef DMA_V
  #undef CMASK
  #undef START
  #undef RESC
  #undef ROT
}
constexpr int ATTN_LDS_BYTES=LDS_BYTES;
struct AttnTensors { const bf16* Q; const bf16* K; const bf16* V; bf16* O; const float* btab; };
struct AttnUnit { int bh; int qb; };
struct StaticOrder {
  int vcu;
  __device__ __forceinline__ explicit StaticOrder(int grid,int block):vcu((block%8)*(grid/8)+block/8){}
  __device__ __forceinline__ bool next(int i,AttnUnit&u)const{ if(i>=16)return false; const int s=vcu&7,ii=i&3; u.bh=(vcu>>3)+32*(i>>2); u.qb=(ii==0)?s:(ii==1)?15-s:(ii==2)?16+s:31-s; return true; }
  __device__ __forceinline__ void a_ready(const AttnUnit&)const{}
  __device__ __forceinline__ void done(const AttnUnit&)const{}
};
template<class Sched,int THRL=8> __device__ __forceinline__ void attn_phase(char*lds,const AttnTensors&T,const Sched&S,int wave_s){
  AttnUnit u;
  for(int i=0;S.next(i,u);++i){ S.a_ready(u); attn_unit<THRL>(u.bh/NHEAD,u.bh%NHEAD,u.qb,T.Q,T.K,T.V,T.O,T.btab,lds,wave_s); S.done(u); }
}
#undef SBAR
#undef WAIT_BAR
}
#define LAS __attribute__((address_space(3)))
typedef unsigned short bf16_t;
typedef short bf16x8 __attribute__((ext_vector_type(8)));
typedef float f32x4 __attribute__((ext_vector_type(4)));
typedef float f32x16 __attribute__((ext_vector_type(16)));
typedef unsigned u32x4 __attribute__((ext_vector_type(4)));
typedef unsigned u32x2 __attribute__((ext_vector_type(2)));
typedef float f32x2_t __attribute__((ext_vector_type(2)));
typedef __bf16 bf16x2_t __attribute__((ext_vector_type(2)));

constexpr int BATCH = 4, SEQ = 8192, DM = 1024, MTOK = BATCH * SEQ, DFF = 2816, NFF = 2 * DFF;
constexpr float EPS = 1e-6f, LOG2E = 1.4426950408889634f;
constexpr float LAMBDA_INIT = 0.35550906f;
constexpr float QSCALE = 0.125f * LOG2E;
constexpr int NWAVES = 8, NTHR = 512;
constexpr int LDS_BYTES = 139264;

constexpr size_t MiB = 1u << 20;
constexpr size_t WS_SSQ = 496 * MiB;
constexpr size_t WS_LB = 1 * MiB;
constexpr size_t WS_BTAB = 1 * MiB + 4096;
constexpr size_t WS_LAM = 1 * MiB + 8192;
constexpr size_t WS_FI00 = 2 * MiB, WS_FI01 = 13 * MiB, WS_FO00 = 24 * MiB, WS_FO01 = 24 * MiB + 5632 * 1024, WS_HIN = 35 * MiB, WS_HOUT = 43 * MiB;
constexpr size_t WS_HB = 45 * MiB;
constexpr size_t WS_BIG = 109 * MiB;
constexpr size_t WS_HID = WS_BIG;
constexpr size_t WS_QH = WS_BIG, WS_LF = WS_BIG + 64 * MiB, WS_VH = WS_BIG + 128 * MiB, WS_GH = WS_BIG + 192 * MiB, WS_UT = WS_BIG + 256 * MiB, WS_DEC = WS_BIG + 384 * MiB;
constexpr size_t WS_W1 = 302 * MiB;
constexpr size_t WS_FI10 = WS_W1, WS_FI11 = WS_W1 + 11 * MiB, WS_FO10 = WS_W1 + 22 * MiB, WS_FO11 = WS_W1 + 22 * MiB + 5632 * 1024, WS_WKV = WS_W1 + 33 * MiB, WS_WQ = WS_W1 + 37 * MiB, WS_WAO = WS_W1 + 39 * MiB;
constexpr size_t WS_KV = 361 * MiB;
constexpr size_t WS_QB = WS_BIG;
constexpr size_t WS_OB = WS_BIG + 64 * MiB;
constexpr size_t WS_END = 511 * MiB;
static_assert(WS_DEC + 2 * MiB <= WS_SSQ && WS_KV + 128 * MiB <= WS_SSQ && WS_SSQ + (size_t)7 * MTOK * 64 <= WS_END && WS_OB + 128 * MiB <= WS_W1 && WS_WAO + 2 * MiB <= WS_KV && WS_HID + (size_t)MTOK * DFF * 2 <= WS_W1, "ws map");

__device__ __forceinline__ float bf2f(unsigned short b) { return __uint_as_float((unsigned)b << 16); }
__device__ __forceinline__ unsigned pkbf(float lo, float hi) { f32x2_t v = {lo, hi}; bf16x2_t b = __builtin_convertvector(v, bf16x2_t); return __builtin_bit_cast(unsigned, b); }
__device__ __forceinline__ unsigned short f2bf(float f) { return (unsigned short)(pkbf(f, 0.f) & 0xffffu); }
__device__ __forceinline__ float fexp(float x) { return __builtin_amdgcn_exp2f(x * LOG2E); }
__device__ __forceinline__ float sigm(float v) { return __builtin_amdgcn_rcpf(1.f + __builtin_amdgcn_exp2f(-v * LOG2E)); }
__device__ __forceinline__ float silu(float v) { return v * sigm(v); }
__device__ __forceinline__ float wave_sum(float v) {
#pragma unroll
    for (int o = 1; o < 64; o <<= 1) v += __shfl_xor(v, o);
    return v;
}
__device__ __forceinline__ int crow(int r, int hi) { return (r & 3) + 8 * (r >> 2) + 4 * hi; }

namespace epi {
using pg8::Unit;
__device__ __forceinline__ float rstd_of(const float* ssq, int row, int fq) {
    const f32x4 a = *(const f32x4*)(ssq + (size_t)row * 16 + fq * 4);
    float t = (a[0] + a[1]) + (a[2] + a[3]);
    t += __shfl_xor(t, 16); t += __shfl_xor(t, 32);
    return rsqrtf(t * (1.f / 1024.f) + EPS);
}

struct EpiSwiglu {
    static constexpr bool PERM = true, AFTER_DRAIN = false;
    bf16_t* H; const float* ssq;
    __device__ __forceinline__ void operator()(const f32x4 (&acc)[2][2][4][2], const Unit& u, int wr, int wc, int fr, int fq) const {
        const int col0 = u.pn * 128 + wc * 32 + 8 * fq;
#pragma unroll
        for (int ai = 0; ai < 2; ++ai)
#pragma unroll
            for (int m = 0; m < 4; ++m) {
                const int row = u.pm * 256 + ai * 128 + wr * 64 + m * 16 + fr; const float r = rstd_of(ssq, row, fq);
                float o[8];
#pragma unroll
                for (int n = 0; n < 2; ++n)
#pragma unroll
                    for (int e = 0; e < 4; ++e) { const float g = acc[ai][0][m][n][e] * r, uu = acc[ai][1][m][n][e] * r; o[n * 4 + e] = silu(g) * uu; }
                u32x4 w; w.x = pkbf(o[0], o[1]); w.y = pkbf(o[2], o[3]); w.z = pkbf(o[4], o[5]); w.w = pkbf(o[6], o[7]);
                *(u32x4*)(H + (size_t)row * DFF + col0) = w;
            }
    }
};
constexpr int LO_BITS = 8;
__device__ __forceinline__ float lo8_dec(unsigned hbits16, int q) {
    const unsigned eb = (hbits16 >> 7) & 0xffu; const float ulp = __uint_as_float(eb > 7u ? (eb - 7u) << 23 : 0u);
    return __uint_as_float(hbits16 << 16) + (float)q * ulp * (1.f / 254.f);
}
__device__ __forceinline__ unsigned lo8_enc(unsigned hbits16, float o) {
    const unsigned eb = (hbits16 >> 7) & 0xffu; const float inv = __uint_as_float(eb > 7u ? (261u - eb) << 23 : 0u);
    const float r = (o - __uint_as_float(hbits16 << 16)) * inv * 254.f;
    return (unsigned)(int)rintf(fminf(fmaxf(r, -127.f), 127.f)) & 0xffu;
}
template <bool BASE_F32, bool OUT_F32>
struct EpiRes {
    static constexpr bool PERM = true, AFTER_DRAIN = false;
    const float* basef; bf16_t* hi; unsigned char* lo; float* outf; float* ssq_out; float alpha;
    __device__ __forceinline__ void operator()(const f32x4 (&acc)[2][2][4][2], const Unit& u, int wr, int wc, int fr, int fq) const {
        const int col0 = u.pn * 256 + wc * 32 + 8 * fq;
#pragma unroll
        for (int ai = 0; ai < 2; ++ai)
#pragma unroll
            for (int m = 0; m < 4; ++m) {
                const int row = u.pm * 256 + ai * 128 + wr * 64 + m * 16 + fr; float s = 0.f;
#pragma unroll
                for (int bj = 0; bj < 2; ++bj) {
                    const size_t off = (size_t)row * DM + col0 + bj * 128;
                    float o[8];
                    if (BASE_F32) {
                        const f32x4 b0 = *(const f32x4*)(basef + off), b1 = *(const f32x4*)(basef + off + 4);
#pragma unroll
                        for (int e = 0; e < 4; ++e) { o[e] = b0[e]; o[4 + e] = b1[e]; }
                    } else {
                        const u32x4 hv = *(const u32x4*)(hi + off);
                        if (LO_BITS == 16) {
                            const u32x4 lv = *(const u32x4*)((const bf16_t*)lo + off);
#pragma unroll
                            for (int k = 0; k < 4; ++k) { o[2 * k] = __uint_as_float(hv[k] << 16) + __uint_as_float(lv[k] << 16); o[2 * k + 1] = __uint_as_float(hv[k] & 0xffff0000u) + __uint_as_float(lv[k] & 0xffff0000u); }
                        } else {
                            const u32x2 lv = *(const u32x2*)(lo + off);
#pragma unroll
                            for (int k = 0; k < 4; ++k) { const unsigned lw = k < 2 ? lv.x : lv.y; const int sh = (k & 1) * 16;
                                o[2 * k] = lo8_dec(hv[k] & 0xffffu, (int)(signed char)((lw >> sh) & 0xffu)); o[2 * k + 1] = lo8_dec(hv[k] >> 16, (int)(signed char)((lw >> (sh + 8)) & 0xffu)); }
                        }
                    }
#pragma unroll
                    for (int e = 0; e < 4; ++e) { o[e] += acc[ai][bj][m][0][e] * alpha; o[4 + e] += acc[ai][bj][m][1][e] * alpha; }
                    if (OUT_F32) {
                        *(f32x4*)(outf + off) = (f32x4){o[0], o[1], o[2], o[3]}; *(f32x4*)(outf + off + 4) = (f32x4){o[4], o[5], o[6], o[7]};
                    } else {
                        u32x4 hw; hw.x = pkbf(o[0], o[1]); hw.y = pkbf(o[2], o[3]); hw.z = pkbf(o[4], o[5]); hw.w = pkbf(o[6], o[7]);
                        *(u32x4*)(hi + off) = hw;
                        if (LO_BITS == 16) {
                            u32x4 lw;
#pragma unroll
                            for (int k = 0; k < 4; ++k) lw[k] = pkbf(o[2 * k] - __uint_as_float(hw[k] << 16), o[2 * k + 1] - __uint_as_float(hw[k] & 0xffff0000u));
                            *(u32x4*)((bf16_t*)lo + off) = lw;
                        } else {
                            unsigned q[8];
#pragma unroll
                            for (int k = 0; k < 4; ++k) { q[2 * k] = lo8_enc(hw[k] & 0xffffu, o[2 * k]); q[2 * k + 1] = lo8_enc(hw[k] >> 16, o[2 * k + 1]); }
                            u32x2 lw; lw.x = q[0] | (q[1] << 8) | (q[2] << 16) | (q[3] << 24); lw.y = q[4] | (q[5] << 8) | (q[6] << 16) | (q[7] << 24);
                            *(u32x2*)(lo + off) = lw;
                        }
                    }
                    s += (o[0] * o[0] + o[1] * o[1]) + (o[2] * o[2] + o[3] * o[3]) + (o[4] * o[4] + o[5] * o[5]) + (o[6] * o[6] + o[7] * o[7]);
                }
                s += __shfl_xor(s, 16); s += __shfl_xor(s, 32);
                if (fq == 0) ssq_out[(size_t)row * 16 + u.pn * 4 + wc] = s;
            }
    }
};
struct EpiBf16 {
    static constexpr bool PERM = true, AFTER_DRAIN = false;
    bf16_t* O; int ldc; const float* ssq; float scale;
    __device__ __forceinline__ void operator()(const f32x4 (&acc)[2][2][4][2], const Unit& u, int wr, int wc, int fr, int fq) const {
        const int col0 = u.pn * 256 + wc * 32 + 8 * fq;
#pragma unroll
        for (int ai = 0; ai < 2; ++ai)
#pragma unroll
            for (int m = 0; m < 4; ++m) {
                const int row = u.pm * 256 + ai * 128 + wr * 64 + m * 16 + fr; const float r = rstd_of(ssq, row, fq) * scale;
#pragma unroll
                for (int bj = 0; bj < 2; ++bj) {
                    const f32x4 v0 = acc[ai][bj][m][0] * r, v1 = acc[ai][bj][m][1] * r;
                    u32x4 w; w.x = pkbf(v0[0], v0[1]); w.y = pkbf(v0[2], v0[3]); w.z = pkbf(v1[0], v1[1]); w.w = pkbf(v1[2], v1[3]);
                    *(u32x4*)(O + (size_t)row * ldc + col0 + bj * 128) = w;
                }
            }
    }
};
struct EpiKV {
    static constexpr bool PERM = true, AFTER_DRAIN = false;
    bf16_t* KK; bf16_t* VV; const float* ssq;
    __device__ __forceinline__ void operator()(const f32x4 (&acc)[2][2][4][2], const Unit& u, int wr, int wc, int fr, int fq) const {
#pragma unroll
        for (int bj = 0; bj < 2; ++bj) {
            const int col = u.pn * 256 + bj * 128 + wc * 32 + 8 * fq;
            bf16_t* basep; size_t bstride;
            if (col < 1024) { const int j = col >> 9, h = (col >> 6) & 7; basep = KK + ((size_t)(j * BATCH * 8 + h) * SEQ) * 64 + (col & 63); bstride = (size_t)8 * SEQ * 64; }
            else { const int c2 = col - 1024, h = c2 >> 7, cv = (c2 >> 6) & 1; basep = VV + ((size_t)(h * 2 + cv) * SEQ) * 64 + (c2 & 63); bstride = (size_t)16 * SEQ * 64; }
#pragma unroll
            for (int ai = 0; ai < 2; ++ai)
#pragma unroll
                for (int m = 0; m < 4; ++m) {
                    const int row = u.pm * 256 + ai * 128 + wr * 64 + m * 16 + fr; const float r = rstd_of(ssq, row, fq);
                    const f32x4 v0 = acc[ai][bj][m][0] * r, v1 = acc[ai][bj][m][1] * r;
                    u32x4 w; w.x = pkbf(v0[0], v0[1]); w.y = pkbf(v0[2], v0[3]); w.z = pkbf(v1[0], v1[1]); w.w = pkbf(v1[2], v1[3]);
                    *(u32x4*)(basep + (size_t)(row >> 13) * bstride + (size_t)(row & (SEQ - 1)) * 64) = w;
                }
        }
    }
};
struct EpiHgrnIn {
    static constexpr bool PERM = true, AFTER_DRAIN = false;
    bf16_t* QH; unsigned short* LF; bf16_t* VH; bf16_t* GH; const float* ssq; const float* lb;
    __device__ __forceinline__ void operator()(const f32x4 (&acc)[2][2][4][2], const Unit& u, int wr, int wc, int fr, int fq) const {
        const int typ = u.pn >> 2; const int col0 = (u.pn & 3) * 256 + wc * 32 + 8 * fq;
        f32x4 lbv[2][2];
#pragma unroll
        for (int bj = 0; bj < 2; ++bj)
#pragma unroll
            for (int n = 0; n < 2; ++n) lbv[bj][n] = (typ == 1) ? *(const f32x4*)(lb + col0 + bj * 128 + 4 * n) : (f32x4){0.f, 0.f, 0.f, 0.f};
        bf16_t* dst = typ == 0 ? QH : (typ == 1 ? (bf16_t*)LF : (typ == 2 ? VH : GH));
#pragma unroll
        for (int ai = 0; ai < 2; ++ai)
#pragma unroll
            for (int m = 0; m < 4; ++m) {
                const int row = u.pm * 256 + ai * 128 + wr * 64 + m * 16 + fr; const float r = rstd_of(ssq, row, fq);
#pragma unroll
                for (int bj = 0; bj < 2; ++bj) {
                    const f32x4 v0 = acc[ai][bj][m][0] * r, v1 = acc[ai][bj][m][1] * r;
                    u32x4 w;
                    if (typ == 1) {
                        unsigned q[8];
#pragma unroll
                        for (int e = 0; e < 8; ++e) { const float x = e < 4 ? v0[e & 3] : v1[e & 3]; const float l = e < 4 ? lbv[bj][0][e & 3] : lbv[bj][1][e & 3];
                            const float f = l + (1.f - l) * sigm(x); const float nl = -__logf(f) * 32768.f; q[e] = (unsigned)fminf(fmaxf(rintf(nl), 0.f), 65535.f); }
                        w.x = q[0] | (q[1] << 16); w.y = q[2] | (q[3] << 16); w.z = q[4] | (q[5] << 16); w.w = q[6] | (q[7] << 16);
                    } else if (typ == 2) {
                        w.x = pkbf(v0[0], v0[1]); w.y = pkbf(v0[2], v0[3]); w.z = pkbf(v1[0], v1[1]); w.w = pkbf(v1[2], v1[3]);
                    } else {
                        w.x = pkbf(silu(v0[0]), silu(v0[1])); w.y = pkbf(silu(v0[2]), silu(v0[3])); w.z = pkbf(silu(v1[0]), silu(v1[1])); w.w = pkbf(silu(v1[2]), silu(v1[3]));
                    }
                    *(u32x4*)(dst + (size_t)row * DM + col0 + bj * 128) = w;
                }
            }
    }
};
}

__device__ __forceinline__ int swmap(int n) { return n < DFF ? ((n >> 7) * 256 + (n & 127)) : (((n - DFF) >> 7) * 256 + 128 + ((n - DFF) & 127)); }
__device__ __forceinline__ void transpose_item(const float* W, int K, int N, bf16_t* WT, const float* nw, int mode, LAS float* scr, int item, int lane) {
    const int nblk = N / 32, kb = item / nblk, nb = item % nblk, k0 = 64 * kb, n0 = 32 * nb;
#pragma unroll 8
    for (int i = 0; i < 32; ++i) { const int kk = 2 * i + (lane >> 5); float v = W[(size_t)(k0 + kk) * N + n0 + (lane & 31)]; if (nw) v *= nw[k0 + kk]; scr[kk * 33 + (lane & 31)] = v; }
    asm volatile("s_waitcnt lgkmcnt(0)" ::: "memory");
    const int c = lane & 7; const int r0 = mode ? swmap(n0) : n0;
#pragma unroll
    for (int j = 0; j < 4; ++j) { const int n = (lane >> 3) + 8 * j; const LAS float* s = scr + (8 * c) * 33 + n;
        u32x4 o; o.x = pkbf(s[0 * 33], s[1 * 33]); o.y = pkbf(s[2 * 33], s[3 * 33]); o.z = pkbf(s[4 * 33], s[5 * 33]); o.w = pkbf(s[6 * 33], s[7 * 33]);
        *(u32x4*)(WT + (size_t)(r0 + n) * K + k0 + 8 * c) = o; }
    asm volatile("s_waitcnt lgkmcnt(0)" ::: "memory");
}
__device__ __forceinline__ void convert_weight(const float* W, int K, int N, bf16_t* WT, const float* nw, int mode, LAS float* scr, int gw, int ngw, int lane) {
    const int nitems = (K / 64) * (N / 32);
    for (int it = gw; it < nitems; it += ngw) transpose_item(W, K, N, WT, nw, mode, scr, it, lane);
}

namespace hg {
constexpr int C = 64, NCH = SEQ / C, NUNIT = BATCH * 8 * NCH;
constexpr int RS = 272, RT = 144;
constexpr int L_QD = 0, L_QI = 64 * RS, L_KI = 2 * 64 * RS, L_SP = 3 * 64 * RS, L_VT = L_SP + 128 * RS, L_AM = L_VT + 128 * RT, L_PART = L_AM + 64 * RT, L_END = L_PART + 2048;
constexpr int L1_KDT = 0, L1_VT = 128 * RT, L1_PART = 2 * 128 * RT;
static_assert(L_END <= 131072, "hgrn lds");

__device__ __forceinline__ void raw16(const unsigned short* P, int unit, int tid, unsigned short (&r)[16]) {
    const int b = unit >> 10, h = (unit >> 7) & 7, n = unit & 127, dk = tid & 127, cq = tid >> 7;
    const unsigned short* p = P + ((size_t)b * SEQ + (size_t)n * C + 16 * cq) * DM + h * 128 + dk;
#pragma unroll
    for (int i = 0; i < 16; ++i) r[i] = p[(size_t)i * DM];
}
__device__ __forceinline__ void bcum_of(const unsigned short (&raw)[16], int dk, int cq, LAS float* part, float (&lf)[16], float (&bc)[16], float& bmid, float& blast) {
#pragma unroll
    for (int i = 0; i < 16; ++i) lf[i] = -(float)raw[i] * (1.f / 32768.f);
    float run = 0.f;
#pragma unroll
    for (int i = 0; i < 16; ++i) { run += lf[i]; bc[i] = run; }
    part[cq * 128 + dk] = run;
    __syncthreads();
    const float p0 = part[dk], p1 = part[128 + dk], p2 = part[256 + dk], p3 = part[384 + dk];
    const float off = cq == 0 ? 0.f : (cq == 1 ? p0 : (cq == 2 ? p0 + p1 : p0 + p1 + p2));
    bmid = p0 + p1; blast = (p0 + p1) + (p2 + p3);
#pragma unroll
    for (int i = 0; i < 16; ++i) bc[i] += off;
}
__device__ __forceinline__ void stage_vt(const unsigned short (&v)[16], int dv, int cq, LAS unsigned char* vt) {
    u32x4 a, b;
    a.x = v[0] | ((unsigned)v[1] << 16); a.y = v[2] | ((unsigned)v[3] << 16); a.z = v[4] | ((unsigned)v[5] << 16); a.w = v[6] | ((unsigned)v[7] << 16);
    b.x = v[8] | ((unsigned)v[9] << 16); b.y = v[10] | ((unsigned)v[11] << 16); b.z = v[12] | ((unsigned)v[13] << 16); b.w = v[14] | ((unsigned)v[15] << 16);
    *(LAS u32x4*)(vt + dv * RT + cq * 32) = a; *(LAS u32x4*)(vt + dv * RT + cq * 32 + 16) = b;
}
__device__ __forceinline__ void h1_phase(LAS unsigned char* L, const unsigned short* LF, const bf16_t* VH, bf16_t* UT, float* DEC, int wave_s) {
    const int tid = fresh_tid(wave_s), lane = tid & 63, w = wave_s, dk = tid & 127, cq = tid >> 7, r32 = lane & 31, hi = lane >> 5;
    unsigned short rlf[16], rv[16];
    if ((int)blockIdx.x < NUNIT) { raw16(LF, blockIdx.x, tid, rlf); raw16(VH, blockIdx.x, tid, rv); }
    for (int unit = blockIdx.x; unit < NUNIT; unit += gridDim.x) {
        float lf[16], bc[16], bmid, blast;
        bcum_of(rlf, dk, cq, (LAS float*)(L + L1_PART), lf, bc, bmid, blast);
        unsigned pk[8];
#pragma unroll
        for (int i = 0; i < 16; i += 2) { const float k0 = (1.f - fexp(lf[i])) * fexp(blast - bc[i]), k1 = (1.f - fexp(lf[i + 1])) * fexp(blast - bc[i + 1]); pk[i >> 1] = pkbf(k0, k1); }
        *(LAS u32x4*)(L + L1_KDT + dk * RT + cq * 32) = (u32x4){pk[0], pk[1], pk[2], pk[3]};
        *(LAS u32x4*)(L + L1_KDT + dk * RT + cq * 32 + 16) = (u32x4){pk[4], pk[5], pk[6], pk[7]};
        stage_vt(rv, dk, cq, L + L1_VT);
        if (cq == 3) DEC[(size_t)unit * 128 + dk] = fexp(blast);
        __syncthreads();
        { const int nu = unit + (int)gridDim.x; if (nu < NUNIT) { raw16(LF, nu, tid, rlf); raw16(VH, nu, tid, rv); } }
        const int dvb = (w & 3) * 32, dkb = (w >> 2) * 64;
        f32x16 acc[2]; acc[0] = f32x16{}; acc[1] = f32x16{};
#pragma unroll
        for (int kk = 0; kk < 4; ++kk) {
            const bf16x8 a = *(const LAS bf16x8*)(L + L1_VT + (dvb + r32) * RT + (kk * 16 + 8 * hi) * 2);
#pragma unroll
            for (int t = 0; t < 2; ++t) { const bf16x8 bb = *(const LAS bf16x8*)(L + L1_KDT + (dkb + 32 * t + r32) * RT + (kk * 16 + 8 * hi) * 2);
                acc[t] = __builtin_amdgcn_mfma_f32_32x32x16_bf16(a, bb, acc[t], 0, 0, 0); }
        }
        bf16_t* up = UT + (size_t)unit * 16384;
#pragma unroll
        for (int t = 0; t < 2; ++t)
#pragma unroll
            for (int r = 0; r < 16; ++r) up[(dvb + crow(r, hi)) * 128 + dkb + 32 * t + r32] = f2bf(acc[t][r]);
        __syncthreads();
    }
}
__device__ __forceinline__ void scan_phase(bf16_t* UT, const float* DEC, int wave_s) {
    const int gt = blockIdx.x * NTHR + fresh_tid(wave_s), ngt = gridDim.x * NTHR;
    for (int g = gt; g < 32 * 4096; g += ngt) {
        const int bh = g >> 12, e = (g & 4095) * 4, dk = e & 127;
        float s0 = 0.f, s1 = 0.f, s2 = 0.f, s3 = 0.f;
        bf16_t* up = UT + (size_t)bh * 128 * 16384 + e; const float* dp = DEC + (size_t)bh * 128 * 128 + dk;
        for (int n0 = 0; n0 < NCH; n0 += 8) {
            u32x2 uu[8]; f32x4 dd[8];
#pragma unroll
            for (int j = 0; j < 8; ++j) { uu[j] = *(const u32x2*)(up + (size_t)(n0 + j) * 16384); dd[j] = *(const f32x4*)(dp + (size_t)(n0 + j) * 128); }
#pragma unroll
            for (int j = 0; j < 8; ++j) {
                u32x2 o; o.x = pkbf(s0, s1); o.y = pkbf(s2, s3);
                *(u32x2*)(up + (size_t)(n0 + j) * 16384) = o;
                s0 = dd[j][0] * s0 + __uint_as_float(uu[j].x << 16); s1 = dd[j][1] * s1 + __uint_as_float(uu[j].x & 0xffff0000u);
                s2 = dd[j][2] * s2 + __uint_as_float(uu[j].y << 16); s3 = dd[j][3] * s3 + __uint_as_float(uu[j].y & 0xffff0000u);
            }
        }
    }
}
__device__ __forceinline__ void h3_load_sp(const bf16_t* SP, int unit, int tid, u32x4 (&sp)[4]) {
    const bf16_t* p = SP + (size_t)unit * 16384;
#pragma unroll
    for (int j = 0; j < 4; ++j) { const int idx = tid + 512 * j; sp[j] = *(const u32x4*)(p + (idx >> 4) * 128 + (idx & 15) * 8); }
}
__device__ __forceinline__ void h3_phase(LAS unsigned char* L, bf16_t* QH, const unsigned short* LF, const bf16_t* VH, const bf16_t* GH, const bf16_t* SP, const float* gnw, int wave_s) {
    const int tid = fresh_tid(wave_s), lane = tid & 63, w = wave_s, dk = tid & 127, cq = tid >> 7, r32 = lane & 31, hi = lane >> 5;
    unsigned short rlf[16], rv[16], rq[16]; u32x4 rsp[4];
    if ((int)blockIdx.x < NUNIT) { raw16(LF, blockIdx.x, tid, rlf); raw16(VH, blockIdx.x, tid, rv); raw16(QH, blockIdx.x, tid, rq); h3_load_sp(SP, blockIdx.x, tid, rsp); }
    for (int unit = blockIdx.x; unit < NUNIT; unit += gridDim.x) {
        const int b = unit >> 10, h = (unit >> 7) & 7, n = unit & 127; const size_t row0 = (size_t)b * SEQ + (size_t)n * C;
#pragma unroll
        for (int j = 0; j < 4; ++j) { const int idx = tid + 512 * j; *(LAS u32x4*)(L + L_SP + (idx >> 4) * RS + (idx & 15) * 16) = rsp[j]; }
        stage_vt(rv, dk, cq, L + L_VT);
        {
            float lf[16], bc[16], bmid, blast;
            bcum_of(rlf, dk, cq, (LAS float*)(L + L_PART), lf, bc, bmid, blast);
#pragma unroll
            for (int i = 0; i < 16; ++i) {
                const float q = bf2f(rq[i]); const float k = 1.f - fexp(lf[i]);
                const int c = 16 * cq + i;
                *(LAS unsigned short*)(L + L_QD + c * RS + dk * 2) = f2bf(q * fexp(bc[i]));
                *(LAS unsigned short*)(L + L_QI + c * RS + dk * 2) = f2bf(q * fexp(bc[i] - bmid));
                *(LAS unsigned short*)(L + L_KI + c * RS + dk * 2) = f2bf(k * fexp(bmid - bc[i]));
            }
        }
        __syncthreads();
        { const int nu = unit + (int)gridDim.x; if (nu < NUNIT) { raw16(LF, nu, tid, rlf); raw16(VH, nu, tid, rv); raw16(QH, nu, tid, rq); h3_load_sp(SP, nu, tid, rsp); } }
        const int ec = tid >> 3, eseg = tid & 7; const size_t eoff = (row0 + ec) * DM + h * 128 + eseg * 16;
        const u32x4 g0 = *(const u32x4*)(GH + eoff), g1 = *(const u32x4*)(GH + eoff + 8);
        if (w < 4) {
            const int cb = (w & 1) * 32, cpb = (w >> 1) * 32;
            f32x16 a = f32x16{};
            if (!(cb == 0 && cpb == 32)) {
#pragma unroll
                for (int kk = 0; kk < 8; ++kk) {
                    const bf16x8 fa = *(const LAS bf16x8*)(L + L_QI + (cb + r32) * RS + (kk * 16 + 8 * hi) * 2);
                    const bf16x8 fb = *(const LAS bf16x8*)(L + L_KI + (cpb + r32) * RS + (kk * 16 + 8 * hi) * 2);
                    a = __builtin_amdgcn_mfma_f32_32x32x16_bf16(fa, fb, a, 0, 0, 0);
                }
            }
#pragma unroll
            for (int r = 0; r < 16; ++r) { const int c = cb + crow(r, hi), cp = cpb + r32; *(LAS unsigned short*)(L + L_AM + c * RT + cp * 2) = f2bf(cp <= c ? a[r] : 0.f); }
        }
        const int cb = (w & 1) * 32, dvb = (w >> 1) * 32;
        f32x16 o = f32x16{};
#pragma unroll
        for (int kk = 0; kk < 8; ++kk) {
            const bf16x8 fa = *(const LAS bf16x8*)(L + L_QD + (cb + r32) * RS + (kk * 16 + 8 * hi) * 2);
            const bf16x8 fb = *(const LAS bf16x8*)(L + L_SP + (dvb + r32) * RS + (kk * 16 + 8 * hi) * 2);
            o = __builtin_amdgcn_mfma_f32_32x32x16_bf16(fa, fb, o, 0, 0, 0);
        }
        __syncthreads();
#pragma unroll
        for (int kk = 0; kk < 4; ++kk) {
            const bf16x8 fa = *(const LAS bf16x8*)(L + L_AM + (cb + r32) * RT + (kk * 16 + 8 * hi) * 2);
            const bf16x8 fb = *(const LAS bf16x8*)(L + L_VT + (dvb + r32) * RT + (kk * 16 + 8 * hi) * 2);
            o = __builtin_amdgcn_mfma_f32_32x32x16_bf16(fa, fb, o, 0, 0, 0);
        }
        __syncthreads();
        LAS float* OF = (LAS float*)(L + L_QD);
#pragma unroll
        for (int r = 0; r < 16; ++r) OF[(cb + crow(r, hi)) * 132 + dvb + r32] = o[r];
        __syncthreads();
        {
            f32x4 v[4]; float ss = 0.f;
#pragma unroll
            for (int j = 0; j < 4; ++j) { v[j] = *(const LAS f32x4*)(OF + ec * 132 + eseg * 16 + 4 * j); ss += (v[j][0] * v[j][0] + v[j][1] * v[j][1]) + (v[j][2] * v[j][2] + v[j][3] * v[j][3]); }
            ss += __shfl_xor(ss, 1); ss += __shfl_xor(ss, 2); ss += __shfl_xor(ss, 4);
            const float rs = rsqrtf(ss * (1.f / 128.f) + EPS);
            const unsigned gg[8] = {g0.x, g0.y, g0.z, g0.w, g1.x, g1.y, g1.z, g1.w};
            unsigned ow[8];
#pragma unroll
            for (int j = 0; j < 4; ++j) {
                const f32x4 wv = *(const f32x4*)(gnw + eseg * 16 + 4 * j);
                const float a0 = v[j][0] * rs * wv[0] * __uint_as_float(gg[2 * j] << 16), a1 = v[j][1] * rs * wv[1] * __uint_as_float(gg[2 * j] & 0xffff0000u);
                const float a2 = v[j][2] * rs * wv[2] * __uint_as_float(gg[2 * j + 1] << 16), a3 = v[j][3] * rs * wv[3] * __uint_as_float(gg[2 * j + 1] & 0xffff0000u);
                ow[2 * j] = pkbf(a0, a1); ow[2 * j + 1] = pkbf(a2, a3);
            }
            *(u32x4*)(QH + eoff) = (u32x4){ow[0], ow[1], ow[2], ow[3]}; *(u32x4*)(QH + eoff + 8) = (u32x4){ow[4], ow[5], ow[6], ow[7]};
        }
        __syncthreads();
    }
}
}

__device__ __forceinline__ void x_prologue(const float* x, bf16_t* hb, float* ssq0, int gw, int ngw, int lane) {
    for (int m = gw; m < MTOK; m += ngw) {
        const f32x4* xr = (const f32x4*)(x + (size_t)m * DM) + lane; f32x4 v[4]; float s = 0.f;
#pragma unroll
        for (int j = 0; j < 4; ++j) { v[j] = xr[64 * j]; s += (v[j][0] * v[j][0] + v[j][1] * v[j][1]) + (v[j][2] * v[j][2] + v[j][3] * v[j][3]); }
        s = wave_sum(s);
        u32x2* o = (u32x2*)(hb + (size_t)m * DM) + lane;
#pragma unroll
        for (int j = 0; j < 4; ++j) { u32x2 w; w.x = pkbf(v[j][0], v[j][1]); w.y = pkbf(v[j][2], v[j][3]); o[64 * j] = w; }
        if (lane < 16) ssq0[(size_t)m * 16 + lane] = lane == 0 ? s : 0.f;
    }
}
__device__ __forceinline__ void combine_phase(const bf16_t* OB, bf16_t* AO, const float* subw, const float* lamp, int wave_s) {
    const float lam = __hip_atomic_load(lamp, __ATOMIC_RELAXED, __HIP_MEMORY_SCOPE_AGENT);
    const int gt = blockIdx.x * NTHR + fresh_tid(wave_s), ngt = gridDim.x * NTHR;
    const int sub = gt & 15;
    f32x4 w0 = *(const f32x4*)(subw + sub * 8), w1 = *(const f32x4*)(subw + sub * 8 + 4);
    for (int g = gt >> 4; g < MTOK * 8; g += ngt >> 4) {
        const int row = g >> 3, h = g & 7;
        const u32x4 a = *(const u32x4*)(OB + (size_t)row * 2048 + h * 128 + sub * 8), bq = *(const u32x4*)(OB + (size_t)row * 2048 + 1024 + h * 128 + sub * 8);
        const unsigned aa[4] = {a.x, a.y, a.z, a.w}, bb[4] = {bq.x, bq.y, bq.z, bq.w};
        float o[8]; float ss = 0.f;
#pragma unroll
        for (int j = 0; j < 4; ++j) { o[2 * j] = __uint_as_float(aa[j] << 16) - lam * __uint_as_float(bb[j] << 16); o[2 * j + 1] = __uint_as_float(aa[j] & 0xffff0000u) - lam * __uint_as_float(bb[j] & 0xffff0000u);
            ss += o[2 * j] * o[2 * j] + o[2 * j + 1] * o[2 * j + 1]; }
        ss += __shfl_xor(ss, 1); ss += __shfl_xor(ss, 2); ss += __shfl_xor(ss, 4); ss += __shfl_xor(ss, 8);
        const float rs = rsqrtf(ss * (1.f / 128.f) + EPS) * (1.f - LAMBDA_INIT);
        u32x4 wv; wv.x = pkbf(o[0] * rs * w0[0], o[1] * rs * w0[1]); wv.y = pkbf(o[2] * rs * w0[2], o[3] * rs * w0[3]); wv.z = pkbf(o[4] * rs * w1[0], o[5] * rs * w1[1]); wv.w = pkbf(o[6] * rs * w1[2], o[7] * rs * w1[3]);
        *(u32x4*)(AO + (size_t)row * DM + h * 128 + sub * 8) = wv;
    }
}
__device__ __forceinline__ void final_norm(const float* src, float* out, const float* fw, int gw, int ngw, int lane) {
    f32x4 wv[4];
#pragma unroll
    for (int j = 0; j < 4; ++j) wv[j] = *((const f32x4*)fw + lane + 64 * j);
    for (int m = gw; m < MTOK; m += ngw) {
        const f32x4* xr = (const f32x4*)(src + (size_t)m * DM) + lane; f32x4* orow = (f32x4*)(out + (size_t)m * DM) + lane; f32x4 v[4]; float s = 0.f;
#pragma unroll
        for (int j = 0; j < 4; ++j) { v[j] = xr[64 * j]; s += (v[j][0] * v[j][0] + v[j][1] * v[j][1]) + (v[j][2] * v[j][2] + v[j][3] * v[j][3]); }
        const float rs = rsqrtf(wave_sum(s) * (1.f / 1024.f) + EPS);
#pragma unroll
        for (int j = 0; j < 4; ++j) orow[64 * j] = v[j] * rs * wv[j];
    }
}
__device__ __forceinline__ int t5_bucket(int n) {
    if (n < 16) return n;
    const float nf = (float)n; int large = 16 + (int)(logf(nf / 16.f) / 2.0794415416798357f * 16.f);
    return large < 31 ? large : 31;
}

struct Args { const float* in[16]; float* out; unsigned char* ws; int ph_lo, ph_hi, coop, pad; };
constexpr int N_PHASES = 19;
#define PROBE_LO (-1)
#define PROBE_HI (-1)
#define PROBE_MULT 4

__global__ void __launch_bounds__(NTHR, 2) yoco_fwd(Args args) {
    extern __shared__ __attribute__((aligned(16))) unsigned char lds[];
    LAS unsigned char* L = (LAS unsigned char*)lds;
    const int wave = __builtin_amdgcn_readfirstlane(threadIdx.x >> 6);
    const int G = gridDim.x, gw = blockIdx.x * NWAVES + wave, ngw = G * NWAVES;
    unsigned char* ws = args.ws;
    const float* x = args.in[0]; const float* norm_w = args.in[1]; const float* ffn_w_in = args.in[2]; const float* ffn_w_out = args.in[3];
    float* ssq = (float*)(ws + WS_SSQ); float* lbv = (float*)(ws + WS_LB); float* btab = (float*)(ws + WS_BTAB); float* lamp = (float*)(ws + WS_LAM);
    bf16_t* HB = (bf16_t*)(ws + WS_HB); bf16_t* HID = (bf16_t*)(ws + WS_HID); float* OUT = args.out;
    const int lo = args.ph_lo, hi = args.ph_hi;
    cg::grid_group grid = cg::this_grid();
#define IN(k) (lo <= (k) && (k) < hi)
#define SEAM(k) do { if (args.coop && IN(k) && IN((k) + 1)) { asm volatile("s_waitcnt vmcnt(0) lgkmcnt(0)" ::: "memory"); grid.sync(); \
        if (wave == 0) asm volatile("s_waitcnt vmcnt(0)" ::: "memory"); __syncthreads(); } } while (0)
#define GEMM_PHASE(EPI, Aptr, Bptr, NN, KK, ...) do { pg8::Gemm g_{(const bf16_t*)(Aptr), (const bf16_t*)(Bptr), MTOK, (NN), (KK)}; pg8::StaticOrder S_; S_.init(MTOK, (NN), G, (int)blockIdx.x); \
        EPI E_{__VA_ARGS__}; pg8::gemm_phase<EPI, pg8::StaticOrder, true, true>(L, g_, S_, E_, wave); } while (0)
    LAS float* scr = (LAS float*)(L + wave * 16384);
    typedef epi::EpiRes<true, false> EpiRes0; typedef epi::EpiRes<false, false> EpiResM; typedef epi::EpiRes<false, true> EpiResL;
    unsigned char* LO = (unsigned char*)args.out;
    float* HF = (float*)(ws + WS_KV);

    unsigned long long pt_s = 0, pt_acc = 0;
#define PB(k) do { if ((k) == PROBE_LO) pt_s = __builtin_amdgcn_s_memrealtime(); } while (0)
#define PE(k) do { if ((k) == PROBE_HI) pt_acc = __builtin_amdgcn_s_memrealtime() - pt_s; } while (0)
    PB(0);
    if (IN(0)) {
        const int tid = fresh_tid(wave), lane = tid & 63;
        convert_weight(ffn_w_in, 1024, NFF, (bf16_t*)(ws + WS_FI00), norm_w + 0 * 1024, 1, scr, gw, ngw, lane);
        convert_weight(ffn_w_in + (size_t)1 * 1024 * NFF, 1024, NFF, (bf16_t*)(ws + WS_FI01), norm_w + 2 * 1024, 1, scr, gw, ngw, lane);
        convert_weight(ffn_w_out, DFF, 1024, (bf16_t*)(ws + WS_FO00), nullptr, 0, scr, gw, ngw, lane);
        convert_weight(ffn_w_out + (size_t)1 * DFF * 1024, DFF, 1024, (bf16_t*)(ws + WS_FO01), nullptr, 0, scr, gw, ngw, lane);
        convert_weight(args.in[4], 1024, 4096, (bf16_t*)(ws + WS_HIN), norm_w + 1 * 1024, 0, scr, gw, ngw, lane);
        convert_weight(args.in[7], 1024, 1024, (bf16_t*)(ws + WS_HOUT), nullptr, 0, scr, gw, ngw, lane);
        x_prologue(x, HB, ssq, gw, ngw, lane);
        if (blockIdx.x == 0) {
            const float* hlb = args.in[5];
            for (int i = tid; i < 1024; i += NTHR) { const float a0 = hlb[i], a1 = hlb[1024 + i]; lbv[i] = 1.f / (1.f + expf(a1 - a0)); }
            const float* rb = args.in[10];
            for (int i = tid; i < 1024; i += NTHR) { const int h = i >> 7, d = i & 127; btab[i] = (rb[t5_bucket(d) * 8 + h] - rb[31 * 8 + h]) * LOG2E; }
            if (wave == 0) { const float* lp = args.in[12]; const float a = wave_sum(lp[lane] * lp[64 + lane]), b2 = wave_sum(lp[128 + lane] * lp[192 + lane]);
                if (lane == 0) *lamp = expf(a) - expf(b2) + LAMBDA_INIT; }
        }
    }
    SEAM(0); PE(0); PB(1);
    if (IN(1)) GEMM_PHASE(epi::EpiSwiglu, HB, ws + WS_FI00, NFF, 1024, HID, ssq + (size_t)0 * MTOK * 16);
    SEAM(1); PE(1); PB(2);
    if (IN(2)) GEMM_PHASE(EpiRes0, HID, ws + WS_FO00, 1024, DFF, x, HB, LO, nullptr, ssq + (size_t)1 * MTOK * 16, 0.5f);
    SEAM(2); PE(2); PB(3);
    if (IN(3)) GEMM_PHASE(epi::EpiHgrnIn, HB, ws + WS_HIN, 4096, 1024, (bf16_t*)(ws + WS_QH), (unsigned short*)(ws + WS_LF), (bf16_t*)(ws + WS_VH), (bf16_t*)(ws + WS_GH), ssq + (size_t)1 * MTOK * 16, lbv);
    SEAM(3); PE(3); PB(4);
    if (IN(4)) hg::h1_phase(L, (const unsigned short*)(ws + WS_LF), (const bf16_t*)(ws + WS_VH), (bf16_t*)(ws + WS_UT), (float*)(ws + WS_DEC), wave);
    SEAM(4); PE(4); PB(5);
    if (IN(5)) hg::scan_phase((bf16_t*)(ws + WS_UT), (const float*)(ws + WS_DEC), wave);
    SEAM(5); PE(5); PB(6);
    if (IN(6)) hg::h3_phase(L, (bf16_t*)(ws + WS_QH), (const unsigned short*)(ws + WS_LF), (const bf16_t*)(ws + WS_VH), (const bf16_t*)(ws + WS_GH), (const bf16_t*)(ws + WS_UT), args.in[6], wave);
    SEAM(6); PE(6); PB(7);
    if (IN(7)) GEMM_PHASE(EpiResM, ws + WS_QH, ws + WS_HOUT, 1024, 1024, nullptr, HB, LO, nullptr, ssq + (size_t)2 * MTOK * 16, 1.0f);
    SEAM(7); PE(7); PB(8);
    if (IN(8)) {
        GEMM_PHASE(epi::EpiSwiglu, HB, ws + WS_FI01, NFF, 1024, HID, ssq + (size_t)2 * MTOK * 16);
        const int lane = fresh_tid(wave) & 63;
        convert_weight(ffn_w_in + (size_t)2 * 1024 * NFF, 1024, NFF, (bf16_t*)(ws + WS_FI10), norm_w + 3 * 1024, 1, scr, gw, ngw, lane);
        convert_weight(ffn_w_in + (size_t)3 * 1024 * NFF, 1024, NFF, (bf16_t*)(ws + WS_FI11), norm_w + 5 * 1024, 1, scr, gw, ngw, lane);
        convert_weight(ffn_w_out + (size_t)2 * DFF * 1024, DFF, 1024, (bf16_t*)(ws + WS_FO10), nullptr, 0, scr, gw, ngw, lane);
        convert_weight(ffn_w_out + (size_t)3 * DFF * 1024, DFF, 1024, (bf16_t*)(ws + WS_FO11), nullptr, 0, scr, gw, ngw, lane);
        convert_weight(args.in[9], 1024, 2048, (bf16_t*)(ws + WS_WKV), args.in[8], 0, scr, gw, ngw, lane);
        convert_weight(args.in[11], 1024, 1024, (bf16_t*)(ws + WS_WQ), norm_w + 4 * 1024, 0, scr, gw, ngw, lane);
        convert_weight(args.in[14], 1024, 1024, (bf16_t*)(ws + WS_WAO), nullptr, 0, scr, gw, ngw, lane);
    }
    SEAM(8); PE(8); PB(9);
    if (IN(9)) GEMM_PHASE(EpiResM, HID, ws + WS_FO01, 1024, DFF, nullptr, HB, LO, nullptr, ssq + (size_t)3 * MTOK * 16, 0.5f);
    SEAM(9); PE(9); PB(10);
    if (IN(10)) {
        GEMM_PHASE(epi::EpiKV, HB, ws + WS_WKV, 2048, 1024, (bf16_t*)(ws + WS_KV), (bf16_t*)(ws + WS_KV + 64 * MiB), ssq + (size_t)3 * MTOK * 16);
        GEMM_PHASE(epi::EpiSwiglu, HB, ws + WS_FI10, NFF, 1024, HID, ssq + (size_t)3 * MTOK * 16);
    }
    SEAM(10); PE(10); PB(11);
    if (IN(11)) GEMM_PHASE(EpiResM, HID, ws + WS_FO10, 1024, DFF, nullptr, HB, LO, nullptr, ssq + (size_t)4 * MTOK * 16, 0.5f);
    SEAM(11); PE(11); PB(12);
    if (IN(12)) GEMM_PHASE(epi::EpiBf16, HB, ws + WS_WQ, 1024, 1024, (bf16_t*)(ws + WS_QB), 1024, ssq + (size_t)4 * MTOK * 16, QSCALE);
    SEAM(12); PE(12); PB(13);
    if (IN(13)) {
        const attn_body::AttnTensors AT{(const attn_body::bf16*)(ws + WS_QB), (const attn_body::bf16*)(ws + WS_KV), (const attn_body::bf16*)(ws + WS_KV + 64 * MiB), (attn_body::bf16*)(ws + WS_OB), btab};
        const attn_body::StaticOrder S((int)G, (int)blockIdx.x);
        attn_body::attn_phase<attn_body::StaticOrder>((char*)lds, AT, S, wave);
    }
    SEAM(13); PE(13); PB(14);
    if (IN(14)) combine_phase((const bf16_t*)(ws + WS_OB), (bf16_t*)(ws + WS_QB), args.in[13], lamp, wave);
    SEAM(14); PE(14); PB(15);
    if (IN(15)) GEMM_PHASE(EpiResM, ws + WS_QB, ws + WS_WAO, 1024, 1024, nullptr, HB, LO, nullptr, ssq + (size_t)5 * MTOK * 16, 1.0f);
    SEAM(15); PE(15); PB(16);
    if (IN(16)) GEMM_PHASE(epi::EpiSwiglu, HB, ws + WS_FI11, NFF, 1024, HID, ssq + (size_t)5 * MTOK * 16);
    SEAM(16); PE(16); PB(17);
    if (IN(17)) GEMM_PHASE(EpiResL, HID, ws + WS_FO11, 1024, DFF, nullptr, HB, LO, HF, ssq + (size_t)6 * MTOK * 16, 0.5f);
    SEAM(17); PE(17); PB(18);
    if (IN(18)) final_norm(HF, OUT, args.in[15], gw, ngw, fresh_tid(wave) & 63);
    PE(18);
    if (PROBE_LO >= 0) { const unsigned long long t0_ = __builtin_amdgcn_s_memrealtime(); while (__builtin_amdgcn_s_memrealtime() - t0_ < PROBE_MULT * pt_acc) __builtin_amdgcn_s_sleep(8); }
#undef IN
#undef SEAM
#undef GEMM_PHASE
}

#ifndef MK_COOP
#define MK_COOP 1
#endif
extern "C" void kernel_launch(void* const* d_in, const int* in_sizes, int n_in, void* d_out, int out_size, void* d_ws, size_t ws_size, hipStream_t stream) {
    static int grid = 0;
    if (grid == 0) {
        if (n_in != 16 || in_sizes[0] != MTOK * DM || out_size != MTOK * DM || ws_size < WS_END) { fprintf(stderr, "kernel_launch: unexpected shapes (n_in %d, in0 %d, out %d, ws %zu)\n", n_in, n_in > 0 ? in_sizes[0] : -1, out_size, ws_size); grid = -1; return; }
        int dev = 0, cus = 0, per_cu = 0;
        hipGetDevice(&dev); hipDeviceGetAttribute(&cus, hipDeviceAttributeMultiprocessorCount, dev);
        hipFuncSetAttribute((const void*)yoco_fwd, hipFuncAttributeMaxDynamicSharedMemorySize, LDS_BYTES);
        hipOccupancyMaxActiveBlocksPerMultiprocessor(&per_cu, (const void*)yoco_fwd, NTHR, LDS_BYTES);
        if (per_cu < 1) { fprintf(stderr, "kernel_launch: occupancy query says %d blocks per CU\n", per_cu); per_cu = 1; }
        (void)hipGetLastError();
        grid = cus;
        if (grid > 256) grid = 256;
        grid &= ~7;
    }
    if (grid <= 0) return;
    Args a{};
    for (int i = 0; i < 16; ++i) a.in[i] = (const float*)d_in[i];
    a.out = (float*)d_out; a.ws = (unsigned char*)d_ws;
#if MK_COOP
    a.ph_lo = 0; a.ph_hi = N_PHASES; a.coop = 1;
    void* kargs[] = {&a};
    hipError_t e = hipLaunchCooperativeKernel((const void*)yoco_fwd, dim3(grid), dim3(NTHR), kargs, LDS_BYTES, stream);
    if (e != hipSuccess) fprintf(stderr, "cooperative launch failed: %s (grid %d)\n", hipGetErrorString(e), grid);
#else
    for (int p = 0; p < N_PHASES; ++p) { a.ph_lo = p; a.ph_hi = p + 1; a.coop = 0; hipLaunchKernelGGL(yoco_fwd, dim3(grid), dim3(NTHR), LDS_BYTES, stream, a); }
#endif
}
```
